# Optimizing an MI355X kernel written in HIP

```python
import jax, jax.numpy as jnp
from jax import lax
import numpy as np

D_MODEL = 1024
BATCH = 4
SEQ = 4096
DEPTH = 1

N_META = 16
BLOCK_Q = 128
EPS = 1e-6
ROPE_THETA = 10000.0
ATT_HEADS = 8
Q_LORA = 256
KV_LORA = 128
QK_NOPE = 64
QK_ROPE = 32
V_HEAD = 64
D_ATT = ATT_HEADS * V_HEAD
D_CONV = D_MODEL - D_ATT
CONV_WIDTH = 3
D_MIX = D_ATT + D_CONV
IN_COLS = Q_LORA + KV_LORA + QK_ROPE + 3 * D_CONV
PEER_HEADS = 8
N_KEYS = 128
N_EXPERTS = N_KEYS * N_KEYS
D_KEY = 256
PEER_TOPK = 16
PEER_BLOCK = 64

kernel_name = 'hymba_mla_shortconv_peer_layer'


def rms_norm(x, g):
    xf = x.astype(jnp.float32)
    y = xf * lax.rsqrt(jnp.mean(xf * xf, axis=-1, keepdims=True) + EPS)
    return (y * g.astype(jnp.float32)).astype(x.dtype)


def rope_tables(L):
    inv = 1.0 / (ROPE_THETA ** (jnp.arange(0, QK_ROPE, 2, dtype=jnp.float32) / QK_ROPE))
    ang = jnp.arange(L, dtype=jnp.float32)[:, None] * inv[None, :]
    return jnp.cos(ang), jnp.sin(ang)


def apply_rope(x, cos, sin):
    xf = x.astype(jnp.float32)
    x1, x2 = xf[..., :QK_ROPE // 2], xf[..., QK_ROPE // 2:]
    return jnp.concatenate([x1 * cos - x2 * sin, x1 * sin + x2 * cos], axis=-1).astype(x.dtype)


def mla_attention(c_q, c_kv, k_rope, q_norm_g, w_uq, kv_norm_g, w_ukv, cos, sin):
    B, L, _ = c_q.shape
    q = jnp.einsum('blr,rf->blf', rms_norm(c_q, q_norm_g), w_uq).reshape(B, L, ATT_HEADS, QK_NOPE + QK_ROPE)
    q_nope = q[..., :QK_NOPE]
    q_rope = apply_rope(q[..., QK_NOPE:], cos[None, :, None], sin[None, :, None])
    kv = jnp.einsum('blr,rf->blf', rms_norm(c_kv, kv_norm_g), w_ukv).reshape(B, L, ATT_HEADS, QK_NOPE + V_HEAD)
    k_nope, v = kv[..., :QK_NOPE], kv[..., QK_NOPE:]
    k_rope = apply_rope(k_rope, cos[None], sin[None])
    q = jnp.concatenate([q_nope, q_rope], axis=-1)
    k = jnp.concatenate([k_nope, jnp.broadcast_to(k_rope[:, :, None], (B, L, ATT_HEADS, QK_ROPE))], axis=-1)
    scale = (QK_NOPE + QK_ROPE) ** -0.5
    n_blk = L // BLOCK_Q
    q_blocks = q.reshape(B, n_blk, BLOCK_Q, ATT_HEADS, QK_NOPE + QK_ROPE).swapaxes(0, 1)
    k_pos = jnp.arange(L)
    neg = jnp.finfo(jnp.float32).min

    def one_block(args):
        qb, i = args
        s = jnp.einsum('bqhd,bkhd->bhqk', qb, k).astype(jnp.float32) * scale
        q_pos = i * BLOCK_Q + jnp.arange(BLOCK_Q)
        s = jnp.where(k_pos[None, :] <= q_pos[:, None], s, neg)
        p = jax.nn.softmax(s, axis=-1).astype(v.dtype)
        return jnp.einsum('bhqk,bkhd->bqhd', p, v)

    out = lax.map(one_block, (q_blocks, jnp.arange(n_blk)))
    return out.swapaxes(0, 1).reshape(B, L, D_ATT)


def short_conv(b_gate, c_gate, u, conv_w, conv_b):
    z = c_gate * u
    zp = jnp.pad(z, ((0, 0), (CONV_WIDTH - 1, 0), (0, 0)))
    L = z.shape[1]
    conv = conv_b + conv_w[0] * zp[:, 0:L] + conv_w[1] * zp[:, 1:L + 1] + conv_w[2] * zp[:, 2:L + 2]
    return b_gate * conv


def peer_ffn(x, w_query, keys1, keys2, u, v):
    B, L, _ = x.shape
    q = jnp.einsum('bld,df->blf', x, w_query).reshape(B, L, PEER_HEADS, 2, D_KEY // 2)
    s1 = jnp.einsum('blhd,nd->blhn', q[..., 0, :], keys1).astype(jnp.float32)
    s2 = jnp.einsum('blhd,nd->blhn', q[..., 1, :], keys2).astype(jnp.float32)
    v1, i1 = lax.top_k(s1, PEER_TOPK)
    v2, i2 = lax.top_k(s2, PEER_TOPK)
    cand = (v1[..., :, None] + v2[..., None, :]).reshape(B, L, PEER_HEADS, PEER_TOPK * PEER_TOPK)
    best, flat = lax.top_k(cand, PEER_TOPK)
    expert = (jnp.take_along_axis(i1, flat // PEER_TOPK, axis=-1) * N_KEYS
              + jnp.take_along_axis(i2, flat % PEER_TOPK, axis=-1))
    gate = jax.nn.softmax(best, axis=-1).astype(x.dtype)
    n_blk = L // PEER_BLOCK

    def blockify(a):
        return a.reshape(B, n_blk, PEER_BLOCK, *a.shape[2:]).swapaxes(0, 1)

    def one_block(args):
        xb, eb, gb = args
        ue = u[eb]
        ve = v[eb]
        act = jax.nn.gelu(jnp.einsum('bthkd,btd->bthk', ue, xb))
        return jnp.einsum('bthk,bthkd->btd', gb * act, ve)

    out = lax.map(one_block, (blockify(x), blockify(expert), blockify(gate)))
    return out.swapaxes(0, 1).reshape(B, L, D_MODEL)


def setup_inputs(seed: int = 0) -> dict:
    key = jax.random.key(seed)
    ks = jax.random.split(key, 24)
    f32 = jnp.float32

    def nrm(k, shape, scale):
        return jax.random.normal(k, shape, f32) * scale

    def gain(k, shape):
        return 1.0 + 0.02 * jax.random.normal(k, shape, f32)

    return {
        'x': nrm(ks[0], (BATCH, SEQ, D_MODEL), 1.0),
        'meta_tokens': nrm(ks[1], (N_META, D_MODEL), 1.0),
        'norm1_g': gain(ks[2], (DEPTH, D_MODEL)),
        'w_in': nrm(ks[3], (DEPTH, D_MODEL, IN_COLS), D_MODEL ** -0.5),
        'q_norm_g': gain(ks[4], (DEPTH, Q_LORA)),
        'w_uq': nrm(ks[5], (DEPTH, Q_LORA, ATT_HEADS * (QK_NOPE + QK_ROPE)), Q_LORA ** -0.5),
        'kv_norm_g': gain(ks[6], (DEPTH, KV_LORA)),
        'w_ukv': nrm(ks[7], (DEPTH, KV_LORA, ATT_HEADS * (QK_NOPE + V_HEAD)), KV_LORA ** -0.5),
        'conv_w': nrm(ks[8], (DEPTH, CONV_WIDTH, D_CONV), CONV_WIDTH ** -0.5),
        'conv_b': nrm(ks[9], (DEPTH, D_CONV), 0.01),
        'attn_out_g': gain(ks[10], (DEPTH, D_ATT)),
        'conv_out_g': gain(ks[11], (DEPTH, D_CONV)),
        'w_out': nrm(ks[12], (DEPTH, D_MIX, D_MODEL), D_MIX ** -0.5),
        'norm2_g': gain(ks[13], (DEPTH, D_MODEL)),
        'peer_w_query': nrm(ks[14], (DEPTH, D_MODEL, PEER_HEADS * D_KEY), D_MODEL ** -0.5),
        'peer_keys1': nrm(ks[15], (DEPTH, N_KEYS, D_KEY // 2), (D_KEY // 2) ** -0.5),
        'peer_keys2': nrm(ks[16], (DEPTH, N_KEYS, D_KEY // 2), (D_KEY // 2) ** -0.5),
        'peer_u': nrm(ks[17], (DEPTH, N_EXPERTS, D_MODEL), D_MODEL ** -0.5),
        'peer_v': nrm(ks[18], (DEPTH, N_EXPERTS, D_MODEL), PEER_HEADS ** -0.5),
        'final_g': gain(ks[19], (D_MODEL,)),
    }


def reference(x, meta_tokens, norm1_g, w_in, q_norm_g, w_uq, kv_norm_g, w_ukv, conv_w, conv_b,
              attn_out_g, conv_out_g, w_out, norm2_g, peer_w_query, peer_keys1, peer_keys2,
              peer_u, peer_v, final_g):
    B, S, _ = x.shape
    L = N_META + S
    L_pad = -(-L // BLOCK_Q) * BLOCK_Q
    meta = jnp.broadcast_to(meta_tokens[None].astype(x.dtype), (B, N_META, D_MODEL))
    h = jnp.concatenate([meta, x], axis=1)
    h = jnp.pad(h, ((0, 0), (0, L_pad - L), (0, 0)))
    cos, sin = rope_tables(L_pad)
    o1 = Q_LORA
    o2 = o1 + KV_LORA
    o3 = o2 + QK_ROPE
    o4 = o3 + D_CONV
    o5 = o4 + D_CONV
    for l in range(DEPTH):
        hn = rms_norm(h, norm1_g[l])
        p = jnp.einsum('bld,df->blf', hn, w_in[l])
        c_q, c_kv, k_rope = p[..., :o1], p[..., o1:o2], p[..., o2:o3]
        b_gate, c_gate, u = p[..., o3:o4], p[..., o4:o5], p[..., o5:]
        attn = mla_attention(c_q, c_kv, k_rope, q_norm_g[l], w_uq[l], kv_norm_g[l], w_ukv[l], cos, sin)
        conv = short_conv(b_gate, c_gate, u, conv_w[l], conv_b[l])
        mixed = jnp.concatenate([rms_norm(attn, attn_out_g[l]), rms_norm(conv, conv_out_g[l])], axis=-1)
        h = h + jnp.einsum('blf,fd->bld', mixed, w_out[l])
        h = h + peer_ffn(rms_norm(h, norm2_g[l]), peer_w_query[l], peer_keys1[l], peer_keys2[l],
                         peer_u[l], peer_v[l])
    return rms_norm(h, final_g)[:, N_META:L]
```

```cpp
#include <hip/hip_runtime.h>
#include <cstdio>
#include <cstdint>

namespace {
constexpr int D_MODEL = 1024, BATCH = 4, SEQ = 4096, N_META = 16;
constexpr int LP = N_META + SEQ;
constexpr int M0 = BATCH * LP;
constexpr float EPS = 1e-6f;
constexpr int ATT_HEADS = 8, Q_LORA = 256, KV_LORA = 128, QK_NOPE = 64, QK_ROPE = 32, V_HEAD = 64;
constexpr int D_ATT = 512, D_CONV = 512, IN_COLS = 1952;
constexpr int O1 = 256, O2 = 384, O3 = 416, O4 = 928, O5 = 1440;
constexpr int PEER_HEADS = 8, N_KEYS = 128, D_KEY = 256, TOPK = 16;
constexpr float NEG_BIG = -1e30f;

__device__ __forceinline__ float wave_sum(float v) {
#pragma unroll
    for (int o = 1; o < 64; o <<= 1) v += __shfl_xor(v, o);
    return v;
}
__device__ __forceinline__ float wave_max(float v) {
#pragma unroll
    for (int o = 1; o < 64; o <<= 1) v = fmaxf(v, __shfl_xor(v, o));
    return v;
}
__device__ __forceinline__ const float* hrow(const float* x, const float* meta, int r) {
    const int b = r / LP, p = r % LP;
    return p < N_META ? meta + (size_t)p * D_MODEL : x + ((size_t)b * SEQ + (p - N_META)) * D_MODEL;
}

template <bool TB>
__global__ void __launch_bounds__(256) k_gemm(const float* __restrict__ A, int lda, const float* __restrict__ B, int ldb,
                                              float* __restrict__ C, int ldc, int M, int N, int K) {
    __shared__ float As[16][68];
    __shared__ float Bs[16][68];
    const int tid = threadIdx.x, tx = tid & 15, ty = tid >> 4;
    const int m0 = blockIdx.y * 64, n0 = blockIdx.x * 64;
    float acc[4][4];
#pragma unroll
    for (int i = 0; i < 4; ++i)
#pragma unroll
        for (int j = 0; j < 4; ++j) acc[i][j] = 0.f;
    for (int k0 = 0; k0 < K; k0 += 16) {
#pragma unroll
        for (int i = 0; i < 4; ++i) {
            const int idx = tid + 256 * i, r = idx >> 4, kk = idx & 15, m = m0 + r;
            As[kk][r] = (m < M) ? A[(size_t)m * lda + k0 + kk] : 0.f;
        }
#pragma unroll
        for (int i = 0; i < 4; ++i) {
            const int idx = tid + 256 * i;
            if (TB) { const int n = idx >> 4, kk = idx & 15, nn = n0 + n; Bs[kk][n] = (nn < N) ? B[(size_t)nn * ldb + k0 + kk] : 0.f; }
            else    { const int kk = idx >> 6, n = idx & 63, nn = n0 + n; Bs[kk][n] = (nn < N) ? B[(size_t)(k0 + kk) * ldb + nn] : 0.f; }
        }
        __syncthreads();
#pragma unroll
        for (int kk = 0; kk < 16; ++kk) {
            float a[4], b[4];
#pragma unroll
            for (int i = 0; i < 4; ++i) { a[i] = As[kk][ty * 4 + i]; b[i] = Bs[kk][tx * 4 + i]; }
#pragma unroll
            for (int i = 0; i < 4; ++i)
#pragma unroll
                for (int j = 0; j < 4; ++j) acc[i][j] += a[i] * b[j];
        }
        __syncthreads();
    }
#pragma unroll
    for (int i = 0; i < 4; ++i) {
        const int m = m0 + ty * 4 + i;
        if (m < M) {
#pragma unroll
            for (int j = 0; j < 4; ++j) { const int n = n0 + tx * 4 + j; if (n < N) C[(size_t)m * ldc + n] = acc[i][j]; }
        }
    }
}

__global__ void __launch_bounds__(256) k_rms1(const float* x, const float* meta, const float* g, float* HN) {
    const int lane = threadIdx.x & 63, r = blockIdx.x * 4 + (threadIdx.x >> 6);
    if (r >= M0) return;
    const float* h = hrow(x, meta, r);
    float v[16], ss = 0.f;
#pragma unroll
    for (int j = 0; j < 16; ++j) { v[j] = h[j * 64 + lane]; ss += v[j] * v[j]; }
    const float rstd = rsqrtf(wave_sum(ss) * (1.f / D_MODEL) + EPS);
#pragma unroll
    for (int j = 0; j < 16; ++j) HN[(size_t)r * D_MODEL + j * 64 + lane] = v[j] * rstd * g[j * 64 + lane];
}

__global__ void __launch_bounds__(256) k_post_p(const float* P, const float* qg, const float* kvg, const float* conv_w, const float* conv_b,
                                                const float* cog, float* CQN, float* CKVN, float* KR, float* MIX) {
    const int lane = threadIdx.x & 63, r = blockIdx.x * 4 + (threadIdx.x >> 6);
    if (r >= M0) return;
    const int p = r % LP;
    const float* pr = P + (size_t)r * IN_COLS;
    {
        float v[4], ss = 0.f;
#pragma unroll
        for (int j = 0; j < 4; ++j) { v[j] = pr[j * 64 + lane]; ss += v[j] * v[j]; }
        const float rstd = rsqrtf(wave_sum(ss) * (1.f / Q_LORA) + EPS);
#pragma unroll
        for (int j = 0; j < 4; ++j) CQN[(size_t)r * Q_LORA + j * 64 + lane] = v[j] * rstd * qg[j * 64 + lane];
    }
    {
        float v[2], ss = 0.f;
#pragma unroll
        for (int j = 0; j < 2; ++j) { v[j] = pr[O1 + j * 64 + lane]; ss += v[j] * v[j]; }
        const float rstd = rsqrtf(wave_sum(ss) * (1.f / KV_LORA) + EPS);
#pragma unroll
        for (int j = 0; j < 2; ++j) CKVN[(size_t)r * KV_LORA + j * 64 + lane] = v[j] * rstd * kvg[j * 64 + lane];
    }
    if (lane < 16) {
        const float inv = 1.0f / powf(10000.0f, (float)(2 * lane) / 32.0f);
        const float ang = (float)p * inv, c = cosf(ang), s = sinf(ang);
        const float x1 = pr[O2 + lane], x2 = pr[O2 + 16 + lane];
        KR[(size_t)r * 32 + lane] = x1 * c - x2 * s;
        KR[(size_t)r * 32 + 16 + lane] = x1 * s + x2 * c;
    }
    {
        float v[8], ss = 0.f;
#pragma unroll
        for (int j = 0; j < 8; ++j) {
            const int c = j * 64 + lane;
            const float z0 = pr[O4 + c] * pr[O5 + c];
            const float z1 = (p >= 1) ? pr[-IN_COLS + O4 + c] * pr[-IN_COLS + O5 + c] : 0.f;
            const float z2 = (p >= 2) ? pr[-2 * IN_COLS + O4 + c] * pr[-2 * IN_COLS + O5 + c] : 0.f;
            const float cv = conv_b[c] + conv_w[c] * z2 + conv_w[D_CONV + c] * z1 + conv_w[2 * D_CONV + c] * z0;
            v[j] = pr[O3 + c] * cv; ss += v[j] * v[j];
        }
        const float rstd = rsqrtf(wave_sum(ss) * (1.f / D_CONV) + EPS);
#pragma unroll
        for (int j = 0; j < 8; ++j) { const int c = j * 64 + lane; MIX[(size_t)r * 1024 + 512 + c] = v[j] * rstd * cog[c]; }
    }
}

__global__ void __launch_bounds__(256) k_rope_q(float* Q) {
    const int idx = blockIdx.x * 256 + threadIdx.x;
    if (idx >= M0 * 128) return;
    const int i = idx & 15, h = (idx >> 4) & 7, r = idx >> 7, p = r % LP;
    const float inv = 1.0f / powf(10000.0f, (float)(2 * i) / 32.0f);
    const float ang = (float)p * inv, c = cosf(ang), s = sinf(ang);
    float* q = Q + (size_t)r * 768 + h * 96 + 64;
    const float x1 = q[i], x2 = q[16 + i];
    q[i] = x1 * c - x2 * s; q[16 + i] = x1 * s + x2 * c;
}

__global__ void __launch_bounds__(256) k_attn(const float* Q, const float* KV, const float* KR, float* ATT) {
    __shared__ float Qs[16][96];
    __shared__ float Kt[96][65];
    __shared__ float Vs[64][64];
    __shared__ float Ps[16][64];
    const int tid = threadIdx.x, lane = tid & 63, w = tid >> 6;
    const int q0 = blockIdx.x * 16, h = blockIdx.y, b = blockIdx.z;
    const size_t rb = (size_t)b * LP;
    for (int idx = tid; idx < 16 * 96; idx += 256) { const int r = idx / 96, d = idx % 96; Qs[r][d] = Q[(rb + q0 + r) * 768 + h * 96 + d]; }
    float m[4], l[4], o[4];
#pragma unroll
    for (int r = 0; r < 4; ++r) { m[r] = NEG_BIG; l[r] = 0.f; o[r] = 0.f; }
    const float scale = 0.10206207261596575f;
    const int nt = (q0 + 15) / 64 + 1;
    for (int kt = 0; kt < nt; ++kt) {
        const int k0 = kt * 64;
        __syncthreads();
        for (int idx = tid; idx < 64 * 96; idx += 256) {
            const int key = idx / 96, d = idx % 96, kp = k0 + key;
            float v = 0.f;
            if (kp < LP) v = d < 64 ? KV[(rb + kp) * 1024 + h * 128 + d] : KR[(rb + kp) * 32 + (d - 64)];
            Kt[d][key] = v;
        }
        for (int idx = tid; idx < 64 * 64; idx += 256) {
            const int key = idx >> 6, d = idx & 63, kp = k0 + key;
            Vs[key][d] = kp < LP ? KV[(rb + kp) * 1024 + h * 128 + 64 + d] : 0.f;
        }
        __syncthreads();
#pragma unroll
        for (int r = 0; r < 4; ++r) {
            const int row = w * 4 + r, qp = q0 + row;
            float s = 0.f;
            for (int d = 0; d < 96; ++d) s += Qs[row][d] * Kt[d][lane];
            s *= scale;
            if (k0 + lane > qp) s = NEG_BIG;
            const float mn = fmaxf(m[r], wave_max(s));
            const float pv = (k0 + lane > qp) ? 0.f : __expf(s - mn);
            const float corr = __expf(m[r] - mn);
            l[r] = l[r] * corr + wave_sum(pv);
            m[r] = mn;
            Ps[row][lane] = pv;
            __builtin_amdgcn_wave_barrier();
            float acc = 0.f;
            for (int k = 0; k < 64; ++k) acc += Ps[row][k] * Vs[k][lane];
            o[r] = o[r] * corr + acc;
        }
    }
#pragma unroll
    for (int r = 0; r < 4; ++r) {
        const int qp = q0 + w * 4 + r;
        ATT[(rb + qp) * 512 + h * 64 + lane] = o[r] / l[r];
    }
}

__global__ void __launch_bounds__(256) k_rms_att(const float* ATT, const float* g, float* MIX) {
    const int lane = threadIdx.x & 63, r = blockIdx.x * 4 + (threadIdx.x >> 6);
    if (r >= M0) return;
    float v[8], ss = 0.f;
#pragma unroll
    for (int j = 0; j < 8; ++j) { v[j] = ATT[(size_t)r * 512 + j * 64 + lane]; ss += v[j] * v[j]; }
    const float rstd = rsqrtf(wave_sum(ss) * (1.f / D_ATT) + EPS);
#pragma unroll
    for (int j = 0; j < 8; ++j) MIX[(size_t)r * 1024 + j * 64 + lane] = v[j] * rstd * g[j * 64 + lane];
}

__global__ void __launch_bounds__(256) k_res_rms2(const float* x, const float* meta, const float* g, float* T, float* XN2) {
    const int lane = threadIdx.x & 63, r = blockIdx.x * 4 + (threadIdx.x >> 6);
    if (r >= M0) return;
    const float* h = hrow(x, meta, r);
    float v[16], ss = 0.f;
#pragma unroll
    for (int j = 0; j < 16; ++j) { v[j] = h[j * 64 + lane] + T[(size_t)r * 1024 + j * 64 + lane]; ss += v[j] * v[j]; }
    const float rstd = rsqrtf(wave_sum(ss) * (1.f / D_MODEL) + EPS);
#pragma unroll
    for (int j = 0; j < 16; ++j) { T[(size_t)r * 1024 + j * 64 + lane] = v[j]; XN2[(size_t)r * 1024 + j * 64 + lane] = v[j] * rstd * g[j * 64 + lane]; }
}

__device__ __forceinline__ void wave_argmax(float& v, int& i) {
#pragma unroll
    for (int o = 32; o >= 1; o >>= 1) {
        const float ov = __shfl_xor(v, o); const int oi = __shfl_xor(i, o);
        if (ov > v || (ov == v && oi < i)) { v = ov; i = oi; }
    }
}
__device__ __forceinline__ void top16_of_128(float a0, float a1, int lane, float& tv, int& ti) {
    tv = 0.f; ti = 0;
    for (int k = 0; k < 16; ++k) {
        float bv; int bi;
        if (a0 >= a1) { bv = a0; bi = lane; } else { bv = a1; bi = lane + 64; }
        wave_argmax(bv, bi);
        if (lane == k) { tv = bv; ti = bi; }
        if (bi == lane) a0 = NEG_BIG * 4.f;
        if (bi == lane + 64) a1 = NEG_BIG * 4.f;
    }
}
__global__ void __launch_bounds__(256) k_topk(const float* S, int head, int* IDX, float* GATE) {
    const int lane = threadIdx.x & 63, r = blockIdx.x * 4 + (threadIdx.x >> 6);
    if (r >= M0) return;
    const float* s = S + (size_t)r * 256;
    float tv1, tv2; int ti1, ti2;
    top16_of_128(s[lane], s[64 + lane], lane, tv1, ti1);
    top16_of_128(s[128 + lane], s[192 + lane], lane, tv2, ti2);
    const int bq = lane & 15;
    const float vb = __shfl(tv2, bq);
    float c0 = __shfl(tv1, (lane >> 4) + 0) + vb, c1 = __shfl(tv1, (lane >> 4) + 4) + vb;
    float c2 = __shfl(tv1, (lane >> 4) + 8) + vb, c3 = __shfl(tv1, (lane >> 4) + 12) + vb;
    float bestv = 0.f; int besti = 0;
    for (int k = 0; k < 16; ++k) {
        float bv = c0; int bi = lane;
        if (c1 > bv) { bv = c1; bi = lane + 64; }
        if (c2 > bv) { bv = c2; bi = lane + 128; }
        if (c3 > bv) { bv = c3; bi = lane + 192; }
        wave_argmax(bv, bi);
        if (lane == k) { bestv = bv; besti = bi; }
        if (bi == lane) c0 = NEG_BIG * 4.f;
        if (bi == lane + 64) c1 = NEG_BIG * 4.f;
        if (bi == lane + 128) c2 = NEG_BIG * 4.f;
        if (bi == lane + 192) c3 = NEG_BIG * 4.f;
    }
    const float mx = __shfl(bestv, 0);
    const float e = lane < 16 ? __expf(bestv - mx) : 0.f;
    const float sum = wave_sum(e);
    const int i1 = __shfl(ti1, (besti >> 4) & 15), i2 = __shfl(ti2, besti & 15);
    if (lane < 16) {
        IDX[(size_t)r * 128 + head * 16 + lane] = i1 * N_KEYS + i2;
        GATE[(size_t)r * 128 + head * 16 + lane] = e / sum;
    }
}

__device__ __forceinline__ float gelu_tanh(float x) {
    const float u = 0.7978845608028654f * (x + 0.044715f * x * x * x);
    return 0.5f * x * (1.f + tanhf(u));
}
__global__ void __launch_bounds__(256) k_peer_final(const float* XN2, const float* H2, const int* IDX, const float* GATE,
                                                    const float* U, const float* V, const float* fg, float* out) {
    const int lane = threadIdx.x & 63, t = blockIdx.x * 4 + (threadIdx.x >> 6);
    if (t >= BATCH * SEQ) return;
    const int b = t / SEQ, s = t % SEQ, r = b * LP + N_META + s;
    float xn[16], acc[16];
#pragma unroll
    for (int j = 0; j < 16; ++j) { xn[j] = XN2[(size_t)r * 1024 + j * 64 + lane]; acc[j] = 0.f; }
    for (int hk = 0; hk < 128; ++hk) {
        const int e = IDX[(size_t)r * 128 + hk];
        const float g = GATE[(size_t)r * 128 + hk];
        const float* ur = U + (size_t)e * 1024; const float* vr = V + (size_t)e * 1024;
        float d = 0.f;
#pragma unroll
        for (int j = 0; j < 16; ++j) d += xn[j] * ur[j * 64 + lane];
        d = wave_sum(d);
        const float coef = g * gelu_tanh(d);
#pragma unroll
        for (int j = 0; j < 16; ++j) acc[j] += coef * vr[j * 64 + lane];
    }
    float ss = 0.f;
#pragma unroll
    for (int j = 0; j < 16; ++j) { acc[j] += H2[(size_t)r * 1024 + j * 64 + lane]; ss += acc[j] * acc[j]; }
    const float rstd = rsqrtf(wave_sum(ss) * (1.f / D_MODEL) + EPS);
#pragma unroll
    for (int j = 0; j < 16; ++j) out[(size_t)t * 1024 + j * 64 + lane] = acc[j] * rstd * fg[j * 64 + lane];
}

template <bool TB>
void gemm(hipStream_t st, const float* A, int lda, const float* B, int ldb, float* C, int ldc, int M, int N, int K) {
    dim3 grid((N + 63) / 64, (M + 63) / 64);
    hipLaunchKernelGGL(k_gemm<TB>, grid, dim3(256), 0, st, A, lda, B, ldb, C, ldc, M, N, K);
}
}

extern "C" void kernel_launch(void* const* d_in, const int* in_sizes, int n_in, void* d_out, int out_size, void* d_ws, size_t ws_size,
                              hipStream_t stream) {
    const float* x = (const float*)d_in[0];
    const float* meta = (const float*)d_in[1];
    const float* norm1_g = (const float*)d_in[2];
    const float* w_in = (const float*)d_in[3];
    const float* q_norm_g = (const float*)d_in[4];
    const float* w_uq = (const float*)d_in[5];
    const float* kv_norm_g = (const float*)d_in[6];
    const float* w_ukv = (const float*)d_in[7];
    const float* conv_w = (const float*)d_in[8];
    const float* conv_b = (const float*)d_in[9];
    const float* attn_out_g = (const float*)d_in[10];
    const float* conv_out_g = (const float*)d_in[11];
    const float* w_out = (const float*)d_in[12];
    const float* norm2_g = (const float*)d_in[13];
    const float* w_query = (const float*)d_in[14];
    const float* keys1 = (const float*)d_in[15];
    const float* keys2 = (const float*)d_in[16];
    const float* peer_u = (const float*)d_in[17];
    const float* peer_v = (const float*)d_in[18];
    const float* final_g = (const float*)d_in[19];
    float* out = (float*)d_out;
    float* ws = (float*)d_ws;
    const size_t R0 = 0, R1 = (size_t)M0 * 1024, R2 = R1 + (size_t)M0 * IN_COLS;
    const size_t need = (R2 + (size_t)M0 * 1024) * 4;
    if (ws_size < need) { fprintf(stderr, "kernel_launch: workspace too small: %zu < %zu\n", ws_size, need); return; }
    float* HN = ws + R0;
    float* P = ws + R1;
    float* MIX = ws + R2;
    float* CQN = ws + R0;
    float* CKVN = CQN + (size_t)M0 * 256;
    float* KR = CKVN + (size_t)M0 * 128;
    float* ATT = KR + (size_t)M0 * 32;
    float* Q = ws + R1;
    float* KV = Q + (size_t)M0 * 768;
    float* T = ws + R1;
    float* XN2 = ws + R0;
    float* QPh = T + (size_t)M0 * 1024;
    float* S = QPh + (size_t)M0 * 256;
    int* IDX = (int*)(S + (size_t)M0 * 256);
    float* GATE = (float*)(IDX + (size_t)M0 * 128);

    const int rowblocks = (M0 + 3) / 4;
    hipLaunchKernelGGL(k_rms1, dim3(rowblocks), dim3(256), 0, stream, x, meta, norm1_g, HN);
    gemm<false>(stream, HN, 1024, w_in, IN_COLS, P, IN_COLS, M0, IN_COLS, 1024);
    hipLaunchKernelGGL(k_post_p, dim3(rowblocks), dim3(256), 0, stream, P, q_norm_g, kv_norm_g, conv_w, conv_b, conv_out_g, CQN, CKVN, KR, MIX);
    gemm<false>(stream, CQN, 256, w_uq, 768, Q, 768, M0, 768, 256);
    gemm<false>(stream, CKVN, 128, w_ukv, 1024, KV, 1024, M0, 1024, 128);
    hipLaunchKernelGGL(k_rope_q, dim3((M0 * 128 + 255) / 256), dim3(256), 0, stream, Q);
    hipLaunchKernelGGL(k_attn, dim3(LP / 16, ATT_HEADS, BATCH), dim3(256), 0, stream, Q, KV, KR, ATT);
    hipLaunchKernelGGL(k_rms_att, dim3(rowblocks), dim3(256), 0, stream, ATT, attn_out_g, MIX);
    gemm<false>(stream, MIX, 1024, w_out, 1024, T, 1024, M0, 1024, 1024);
    hipLaunchKernelGGL(k_res_rms2, dim3(rowblocks), dim3(256), 0, stream, x, meta, norm2_g, T, XN2);
    for (int h = 0; h < PEER_HEADS; ++h) {
        gemm<false>(stream, XN2, 1024, w_query + h * D_KEY, PEER_HEADS * D_KEY, QPh, 256, M0, 256, 1024);
        gemm<true>(stream, QPh, 256, keys1, 128, S, 256, M0, 128, 128);
        gemm<true>(stream, QPh + 128, 256, keys2, 128, S + 128, 256, M0, 128, 128);
        hipLaunchKernelGGL(k_topk, dim3(rowblocks), dim3(256), 0, stream, S, h, IDX, GATE);
    }
    hipLaunchKernelGGL(k_peer_final, dim3(BATCH * SEQ / 4), dim3(256), 0, stream, XN2, T, IDX, GATE, peer_u, peer_v, final_g, out);
}
```

```cpp
#include <hip/hip_runtime.h>
#include <cstdio>
#include <cstdint>
namespace pg8 {
#define PG8_LAS __attribute__((address_space(3)))
typedef unsigned short bf16_t;
typedef short bf16x8 __attribute__((ext_vector_type(8)));
typedef float f32x4 __attribute__((ext_vector_type(4)));
typedef unsigned u32x4 __attribute__((ext_vector_type(4)));
typedef unsigned u32x2 __attribute__((ext_vector_type(2)));
constexpr int BM = 256, BK = 64, HALF = 128, HTB = HALF * BK * 2  , STAGE_BYTES = 8 * HTB, NXCD = 8, WGM = 8;

__host__ __device__ __forceinline__ int lds_byte(int r, int c) { const int st = (r >> 4) * 2 + (c >> 5), rr = r & 15, cc = c & 31, ob = rr * 64 + cc * 2; return st * 1024 + (ob ^ (((ob >> 9) & 1) << 5)); }
__host__ __device__ __forceinline__ void stage_rc(int b, int& R, int& C) { const int st = b / 1024, sb = b % 1024, swz = sb ^ (((sb >> 9) & 1) << 5); R = (st >> 1) * 16 + swz / 64; C = (st & 1) * 32 + (swz % 64) / 2; }
__host__ __device__ __forceinline__ int perm32(int rho) { const int n = rho >> 4, i = rho & 15; return 8 * (i >> 2) + 4 * n + (i & 3); }

struct Unit { int pm, pn; };
struct Gemm { const bf16_t* A; const bf16_t* Bt; int M, N, K, lda, ldb; };

struct StaticOrder {
    int nM, nN, nwg, G, c;
    __host__ __device__ __forceinline__ void init(int M, int N, int G_, int c_) { nM = M / BM; nN = N / BM; nwg = nM * nN; G = G_; c = c_; }
    __host__ __device__ __forceinline__ bool next(int i, Unit& u) const {
        const long L = (long)i * G + c; if (L >= nwg) return false;
        int wgid = (int)L; { const int q = nwg / NXCD, r = nwg % NXCD, xcd = wgid % NXCD, off = wgid / NXCD; wgid = (xcd < r ? xcd * (q + 1) : r * (q + 1) + (xcd - r) * q) + off; }
        const int nig = WGM * nN, gid = wgid / nig, fm = gid * WGM, gsz = (nM - fm) < WGM ? (nM - fm) : WGM;
        u.pm = fm + ((wgid % nig) % gsz); u.pn = (wgid % nig) / gsz; return true;
    }
};

__device__ __forceinline__ unsigned cvt_pk_bf16(float lo, float hi) { unsigned r; asm volatile("v_cvt_pk_bf16_f32 %0, %1, %2" : "=v"(r) : "v"(lo), "v"(hi)); return r; }

template <class Epi, class Sched, bool ALIGN_EPI = false, bool SP2 = false>
__device__ __forceinline__ void gemm_phase(PG8_LAS unsigned char* lds, const Gemm g, const Sched& S, const Epi& E, const int wave_id) {
    int lane_ = (int)__builtin_amdgcn_mbcnt_hi(~0u, __builtin_amdgcn_mbcnt_lo(~0u, 0u)); asm volatile("" : "+v"(lane_));
    const int wid = wave_id, lane = lane_, tid = wid * 64 + lane, wr = wid >> 2, wc = wid & 3, fr = lane & 15, fq = lane >> 4;
    const int K = g.K, nt = K / BK;
    unsigned voffA[2], voffB[2];
#pragma unroll
    for (int i = 0; i < 2; ++i) { int R, C; stage_rc(tid * 16 + i * 8192, R, C); const int Rb = Epi::PERM ? ((R & ~31) + perm32(R & 31)) : R;
        voffA[i] = (unsigned)(R * g.lda + C) * 2u; voffB[i] = (unsigned)(Rb * g.ldb + C) * 2u; }
    const size_t kstep = (size_t)(BK * 2);
    const size_t hstepA = (size_t)HALF * g.lda * 2, hstepB = (size_t)HALF * g.ldb * 2;
    const size_t tstepA = 2 * hstepA, tstepB = 2 * hstepB;
    const unsigned ldsw = (unsigned)wid * 1024u;
    const int aoff = lds_byte(wr * 64 + fr, fq * 8), boff = lds_byte(wc * 32 + fr, fq * 8);
#define PG8_SA(b, h) (((b) * 2 + (h)) * HTB)
#define PG8_SB(b, h) ((4 + (b) * 2 + (h)) * HTB)
#define PG8_STAGE(bufoff, gbase, voff) do { _Pragma("unroll") for (int _i = 0; _i < 2; ++_i) \
        __builtin_amdgcn_global_load_lds((const unsigned*)((const char*)(gbase) + (voff)[_i]), (PG8_LAS unsigned*)(lds + (bufoff) + ldsw + _i * 8192), 16, 0, 0); } while (0)
#define PG8_LDA(dst, b, h) do { _Pragma("unroll") for (int m = 0; m < 4; ++m) _Pragma("unroll") for (int k = 0; k < 2; ++k) dst[m][k] = *(const PG8_LAS bf16x8*)(lds + PG8_SA(b, h) + aoff + m * 2048 + k * 1024); } while (0)
#define PG8_LDB(dst, b, h) do { _Pragma("unroll") for (int n = 0; n < 2; ++n) _Pragma("unroll") for (int k = 0; k < 2; ++k) dst[n][k] = *(const PG8_LAS bf16x8*)(lds + PG8_SB(b, h) + boff + n * 2048 + k * 1024); } while (0)
#define PG8_MMA(ai, bj, At, Bt) do { __builtin_amdgcn_s_setprio(1); _Pragma("unroll") for (int m = 0; m < 4; ++m) _Pragma("unroll") for (int n = 0; n < 2; ++n) _Pragma("unroll") for (int k = 0; k < 2; ++k) \
        acc[ai][bj][m][n] = __builtin_amdgcn_mfma_f32_16x16x32_bf16(Bt[n][k], At[m][k], acc[ai][bj][m][n], 0, 0, 0); __builtin_amdgcn_s_setprio(0); } while (0)
#define PG8_WAIT_V(n) asm volatile("s_waitcnt vmcnt(" #n ")" ::: "memory")
#define PG8_WAIT_L(n) asm volatile("s_waitcnt lgkmcnt(" #n ")" ::: "memory")
#define PG8_BAR __builtin_amdgcn_s_barrier()
#define PG8_SCHED __builtin_amdgcn_sched_barrier(0)
    Unit cur, nxt; int ui = 0;
    if (!S.next(0, cur)) return;
    f32x4 acc[2][2][4][2];
#pragma unroll
    for (int a = 0; a < 2; ++a)
#pragma unroll
        for (int b = 0; b < 2; ++b)
#pragma unroll
            for (int m = 0; m < 4; ++m)
#pragma unroll
                for (int n = 0; n < 2; ++n) acc[a][b][m][n] = (f32x4){0.f, 0.f, 0.f, 0.f};
    bf16x8 At[4][2], B0[2][2], B1[2][2];
    const char* cA = (const char*)g.A + (size_t)cur.pm * tstepA; const char* cB = (const char*)g.Bt + (size_t)cur.pn * tstepB;
    if constexpr (SP2) {
        PG8_STAGE(PG8_SB(0, 0), cB, voffB); PG8_STAGE(PG8_SB(0, 1), cB + hstepB, voffB); PG8_STAGE(PG8_SA(0, 0), cA, voffA); PG8_STAGE(PG8_SA(0, 1), cA + hstepA, voffA);
        if (wr == 1) PG8_BAR;
        PG8_WAIT_V(2); PG8_BAR;
        PG8_STAGE(PG8_SB(1, 0), cB + kstep, voffB); PG8_STAGE(PG8_SA(1, 0), cA + kstep, voffA); PG8_STAGE(PG8_SB(1, 1), cB + hstepB + kstep, voffB);
        PG8_WAIT_V(6); PG8_BAR;
    } else {
        PG8_STAGE(PG8_SB(0, 0), cB, voffB); PG8_STAGE(PG8_SA(0, 0), cA, voffA); PG8_STAGE(PG8_SB(0, 1), cB + hstepB, voffB); PG8_STAGE(PG8_SA(0, 1), cA + hstepA, voffA);
        if (wr == 1) PG8_BAR;
        PG8_WAIT_V(4); PG8_BAR;
        PG8_STAGE(PG8_SB(1, 0), cB + kstep, voffB); PG8_STAGE(PG8_SA(1, 0), cA + kstep, voffA); PG8_STAGE(PG8_SB(1, 1), cB + hstepB + kstep, voffB);
        PG8_WAIT_V(6); PG8_BAR;
    }
    for (;;) {
        const bool has_next = S.next(ui + 1, nxt);
        const char* nA = has_next ? (const char*)g.A + (size_t)nxt.pm * tstepA : cA; const char* nB = has_next ? (const char*)g.Bt + (size_t)nxt.pn * tstepB : cB;
        for (int t = 0; t < nt; t += 2) {
            const bool last = (t == nt - 2);
            const char* a1 = cA + (size_t)(t + 1) * kstep;
            const char* a2 = last ? nA : cA + (size_t)(t + 2) * kstep; const char* b2 = last ? nB : cB + (size_t)(t + 2) * kstep;
            const char* a3 = a2 + kstep; const char* b3 = b2 + kstep;
            if constexpr (Epi::HAS_MID) { if (t == E.mid_t) E.mid(acc, cur, wr, wc, fr, fq); }
            if constexpr (SP2) {
            PG8_LDB(B0, 0, 0); PG8_LDB(B1, 0, 1); PG8_SCHED; PG8_LDA(At, 0, 0); PG8_STAGE(PG8_SA(1, 1), a1 + hstepA, voffA);
            PG8_WAIT_V(8); PG8_WAIT_L(0); PG8_BAR; PG8_MMA(0, 0, At, B0); PG8_MMA(0, 1, At, B1); PG8_BAR; PG8_SCHED;
            PG8_LDA(At, 0, 1); PG8_STAGE(PG8_SB(0, 0), b2, voffB); PG8_STAGE(PG8_SB(0, 1), b2 + hstepB, voffB); PG8_STAGE(PG8_SA(0, 0), a2, voffA);
            PG8_WAIT_V(8); PG8_WAIT_L(0); PG8_BAR; PG8_MMA(1, 0, At, B0); PG8_MMA(1, 1, At, B1); PG8_BAR; PG8_SCHED;
            PG8_LDB(B0, 1, 0); PG8_LDB(B1, 1, 1); PG8_SCHED; PG8_LDA(At, 1, 0); PG8_STAGE(PG8_SA(0, 1), a2 + hstepA, voffA);
            PG8_WAIT_V(8); PG8_WAIT_L(0); PG8_BAR; PG8_MMA(0, 0, At, B0); PG8_MMA(0, 1, At, B1); PG8_BAR; PG8_SCHED;
            PG8_LDA(At, 1, 1); PG8_STAGE(PG8_SB(1, 0), b3, voffB); PG8_STAGE(PG8_SB(1, 1), b3 + hstepB, voffB); PG8_STAGE(PG8_SA(1, 0), a3, voffA);
            PG8_WAIT_V(8); PG8_WAIT_L(0); PG8_BAR; PG8_MMA(1, 0, At, B0); PG8_MMA(1, 1, At, B1); PG8_BAR; PG8_SCHED;
            } else {
            PG8_LDB(B0, 0, 0); PG8_SCHED; PG8_LDA(At, 0, 0); PG8_STAGE(PG8_SA(1, 1), a1 + hstepA, voffA);
            PG8_WAIT_L(8); PG8_BAR; PG8_WAIT_L(0); PG8_MMA(0, 0, At, B0); PG8_BAR; PG8_SCHED;
            PG8_LDB(B1, 0, 1); PG8_STAGE(PG8_SB(0, 0), b2, voffB);
            PG8_BAR; PG8_WAIT_L(0); PG8_MMA(0, 1, At, B1); PG8_BAR;
            PG8_LDA(At, 0, 1); PG8_STAGE(PG8_SA(0, 0), a2, voffA);
            PG8_BAR; PG8_WAIT_L(0); PG8_MMA(1, 0, At, B0); PG8_BAR; PG8_SCHED;
            PG8_STAGE(PG8_SB(0, 1), b2 + hstepB, voffB);
            PG8_WAIT_V(6); PG8_BAR; PG8_MMA(1, 1, At, B1); PG8_BAR;
            PG8_LDB(B0, 1, 0); PG8_SCHED; PG8_LDA(At, 1, 0); PG8_STAGE(PG8_SA(0, 1), a2 + hstepA, voffA);
            PG8_WAIT_L(8); PG8_BAR; PG8_WAIT_L(0); PG8_MMA(0, 0, At, B0); PG8_BAR; PG8_SCHED;
            PG8_LDB(B1, 1, 1); PG8_STAGE(PG8_SB(1, 0), b3, voffB);
            PG8_BAR; PG8_WAIT_L(0); PG8_MMA(0, 1, At, B1); PG8_BAR;
            PG8_LDA(At, 1, 1); PG8_STAGE(PG8_SA(1, 0), a3, voffA);
            PG8_BAR; PG8_WAIT_L(0); PG8_MMA(1, 0, At, B0); PG8_BAR; PG8_SCHED;
            PG8_STAGE(PG8_SB(1, 1), b3 + hstepB, voffB);
            PG8_WAIT_V(6); PG8_BAR; PG8_MMA(1, 1, At, B1); PG8_BAR;
            }
        }
        if constexpr (ALIGN_EPI) { if (wr == 0) PG8_BAR; }
        E(acc, cur, wr, wc, fr, fq);
        if (!has_next) break;
#pragma unroll
        for (int a = 0; a < 2; ++a)
#pragma unroll
            for (int b = 0; b < 2; ++b)
#pragma unroll
                for (int m = 0; m < 4; ++m)
#pragma unroll
                    for (int n = 0; n < 2; ++n) acc[a][b][m][n] = (f32x4){0.f, 0.f, 0.f, 0.f};
        cur = nxt; cA = nA; cB = nB; ++ui;
        if constexpr (ALIGN_EPI) { if (wr == 1) PG8_BAR; }
    }
    PG8_WAIT_V(0);
    if constexpr (!ALIGN_EPI) { if (wr == 0) PG8_BAR; }
    PG8_BAR;
#undef PG8_SA
#undef PG8_SB
#undef PG8_STAGE
#undef PG8_LDA
#undef PG8_LDB
#undef PG8_MMA
#undef PG8_WAIT_V
#undef PG8_WAIT_L
#undef PG8_BAR
#undef PG8_SCHED
}
}
namespace {
constexpr int D_MODEL = 1024, BATCH = 4, SEQ = 4096, N_META = 16;
constexpr int M = BATCH * SEQ;
constexpr float EPS = 1e-6f;
constexpr int IN_COLS = 1952, PN = 2048;
constexpr int O1 = 256, O2 = 384, O3 = 416, O4 = 928, O5 = 1440;
constexpr int KVROWS = 64 + SEQ;
constexpr int NEXP = 16384;
constexpr float QSCALE = 0.10206207261596575f * 1.4426950408889634f;
constexpr int NWAVES = 8;

constexpr size_t MiB = 1u << 20;
constexpr size_t WS_CTL = 0, CTL_ZERO_BYTES = 64 * 1024;
constexpr size_t WS_SMALL = 1 * MiB;
constexpr size_t WS_WIN = 4 * MiB;
constexpr size_t WS_WQ = 8 * MiB;
constexpr size_t WS_WOUT = 12 * MiB;
constexpr size_t WS_WUQ = 14 * MiB;
constexpr size_t WS_WUKV = 14 * MiB + 512 * 1024;
constexpr size_t WS_KEYS = 14 * MiB + 768 * 1024;
constexpr size_t WS_U = 15 * MiB;
constexpr size_t WS_V = 31 * MiB;
constexpr size_t WS_Q = 44 * MiB;
constexpr size_t WS_P = 79 * MiB;
constexpr size_t WS_XB = 143 * MiB;
constexpr size_t WS_KN = 175 * MiB;
constexpr size_t WS_VV = 192 * MiB;
constexpr size_t WS_KR = 209 * MiB;
constexpr size_t WS_MIX = 211 * MiB;
constexpr size_t WS_IDX = WS_MIX, WS_GATE = WS_MIX + 8 * MiB;
constexpr size_t WS_PMP = 243 * MiB;
constexpr size_t WS_END = 245 * MiB;
constexpr int SM_RSTD1 = 0;
constexpr int SM_SSQQ = SM_RSTD1 + M;
constexpr int SM_SSQKV = SM_SSQQ + 4 * M;
constexpr int SM_SSQATT = SM_SSQKV + 4 * M;
constexpr int SM_SSQ2 = SM_SSQATT + 8 * M;
constexpr int SM_ZMETA = SM_SSQ2 + 16 * M;
constexpr int SM_ROPE = SM_ZMETA + 1024;
constexpr int SM_SU = SM_ROPE + (N_META + SEQ) * 32;
constexpr int SM_SV = SM_SU + NEXP;
constexpr int SM_END = SM_SV + NEXP;
static_assert((size_t)SM_END * 4 <= 3 * MiB, "small arrays");
static_assert(WS_KN + (size_t)BATCH * KVROWS * 512 * 2 <= WS_VV && WS_VV + (size_t)BATCH * KVROWS * 512 * 2 <= WS_KR && WS_KR + (size_t)BATCH * KVROWS * 64 <= WS_MIX, "kv map");
constexpr int CW_BAR = 1024;

constexpr int RING_OFF = 0, RING_BYTES = 131072;
constexpr int LDSCTL_OFF = RING_BYTES, MISC_OFF = LDSCTL_OFF + 320;
constexpr int TAB_OFF = RING_BYTES + 1024;
constexpr int LDS_BYTES = 147456;

#define GAS __attribute__((address_space(1)))
#define LAS __attribute__((address_space(3)))
typedef unsigned short bf16;
typedef unsigned v4u __attribute__((ext_vector_type(4)));
typedef unsigned v2u __attribute__((ext_vector_type(2)));
typedef float f32x4 __attribute__((ext_vector_type(4)));
typedef GAS unsigned gu32;
#define RLX_AGENT __ATOMIC_RELAXED, __HIP_MEMORY_SCOPE_AGENT
#define LDS_WAIT() asm volatile("s_waitcnt lgkmcnt(0)" ::: "memory")
#define VM_WAIT() asm volatile("s_waitcnt vmcnt(0)" ::: "memory")
__device__ __forceinline__ unsigned f2bf(float f) { unsigned u = __builtin_bit_cast(unsigned, f); return (u + 0x7fffu + ((u >> 16) & 1u)) >> 16; }
__device__ __forceinline__ unsigned pk2(float lo, float hi) { return f2bf(lo) | (f2bf(hi) << 16); }
__device__ __forceinline__ float bf_lo(unsigned w) { return __builtin_bit_cast(float, w << 16); }
__device__ __forceinline__ float bf_hi(unsigned w) { return __builtin_bit_cast(float, w & 0xffff0000u); }
__device__ __forceinline__ float bf2f(bf16 h) { return __builtin_bit_cast(float, (unsigned)h << 16); }
template <int CTRL> __device__ __forceinline__ float fdpp(float v) { return __builtin_bit_cast(float, __builtin_amdgcn_update_dpp(0, __builtin_bit_cast(int, v), CTRL, 0xF, 0xF, false)); }
__device__ __forceinline__ int lane_id64() { int l = (int)__builtin_amdgcn_mbcnt_hi(~0u, __builtin_amdgcn_mbcnt_lo(~0u, 0u)); asm volatile("" : "+v"(l)); return l; }
__device__ __forceinline__ int ix32(int v) { return __builtin_amdgcn_ds_bpermute((lane_id64() ^ 32) << 2, v); }
__device__ __forceinline__ float wave_sum(float v) {
    v += fdpp<0x128>(v); v += fdpp<0x141>(v); v += fdpp<0x4E>(v); v += fdpp<0xB1>(v);
    float a = v, b = v; asm volatile("s_nop 1\n\tv_permlane16_swap_b32 %0, %1" : "+v"(a), "+v"(b)); a += b; b = a;
    asm volatile("s_nop 1\n\tv_permlane32_swap_b32 %0, %1" : "+v"(a), "+v"(b)); return a + b;
}
__device__ __forceinline__ float wave_max(float v) {
    v = fmaxf(v, fdpp<0x128>(v)); v = fmaxf(v, fdpp<0x141>(v)); v = fmaxf(v, fdpp<0x4E>(v)); v = fmaxf(v, fdpp<0xB1>(v));
    float a = v, b = v; asm volatile("s_nop 1\n\tv_permlane16_swap_b32 %0, %1" : "+v"(a), "+v"(b)); a = fmaxf(a, b); b = a;
    asm volatile("s_nop 1\n\tv_permlane32_swap_b32 %0, %1" : "+v"(a), "+v"(b)); return fmaxf(a, b);
}

__device__ __forceinline__ float half_max(float v) {
    v = fmaxf(v, fdpp<0x128>(v)); v = fmaxf(v, fdpp<0x141>(v)); v = fmaxf(v, fdpp<0x4E>(v)); v = fmaxf(v, fdpp<0xB1>(v));
    float a = v, b = v; asm volatile("s_nop 1\n\tv_permlane16_swap_b32 %0, %1" : "+v"(a), "+v"(b)); return fmaxf(a, b);
}
typedef _Float16 v32h __attribute__((ext_vector_type(32)));
typedef unsigned v6u __attribute__((ext_vector_type(6)));

#define XB_TMO      128
#define XB_XCNT(j)  (256  + 64 * (j))
#define XB_XSUB(j)  (1280 + 64 * (j))
#define XB_XGEN(j)  (2304 + 64 * (j))
#define XB_TOP      3328
#define XB_TOPGEN   3392
#define XCD_BAR_WORDS 3456
#define XB_SPIN_CAP (1u << 18)
__device__ __forceinline__ unsigned xb_ld(unsigned* p)              { return __hip_atomic_load(p, __ATOMIC_RELAXED, __HIP_MEMORY_SCOPE_AGENT); }
__device__ __forceinline__ unsigned xb_add(unsigned* p, unsigned v) { return __hip_atomic_fetch_add(p, v, __ATOMIC_RELAXED, __HIP_MEMORY_SCOPE_AGENT); }
__device__ __forceinline__ unsigned xb_xcc_id() { return (unsigned)__builtin_amdgcn_s_getreg((3 << 11) | 20) & 0xFu; }
#define XB_SPIN(cond, bar) do { unsigned _sp = 0; while (cond) { __builtin_amdgcn_s_sleep(1); \
    if ((++_sp & 255u) == 0u) { if (xb_ld(&(bar)[XB_TMO])) break; if (_sp > XB_SPIN_CAP) { atomicAdd(&(bar)[XB_TMO], 1u); break; } } } } while (0)
struct XcdBarrier { unsigned* bar; unsigned x; volatile LAS unsigned* st; int wave; };
__device__ __forceinline__ XcdBarrier xcd_barrier_post(unsigned* bar, volatile LAS unsigned* st, int wave) {
    XcdBarrier b; b.bar = bar; b.x = xb_xcc_id(); b.st = st; b.wave = wave;
    if (wave == 0 && lane_id64() == 0) (void)xb_add(&bar[XB_XCNT(b.x)], 1u);
    return b;
}
__device__ __forceinline__ void xcd_barrier_complete(unsigned* bar, unsigned x, unsigned& nloc, unsigned& nx) {
    const unsigned G = gridDim.x * gridDim.y * gridDim.z;
    unsigned sum, cnt, mine, sp = 0u;
    for (;;) {
        sum = 0u; cnt = 0u; mine = 0u;
#pragma unroll
        for (unsigned j = 0; j < 16; ++j) { const unsigned c = xb_ld(&bar[XB_XCNT(j)]); sum += c; cnt += (c > 0u) ? 1u : 0u; mine = (j == x) ? c : mine; }
        if (sum == G) break;
        __builtin_amdgcn_s_sleep(1);
        if ((++sp & 255u) == 0u) { if (xb_ld(&bar[XB_TMO])) break; if (sp > XB_SPIN_CAP) { atomicAdd(&bar[XB_TMO], 1u); break; } }
    }
    nloc = mine > 0u ? mine : 1u; nx = cnt > 0u ? cnt : 1u;
}
__device__ __forceinline__ void xcd_barrier(const XcdBarrier& b) {
    asm volatile("s_waitcnt vmcnt(0)" ::: "memory");
    __syncthreads();
    if (b.wave == 0 && lane_id64() == 0) {
        unsigned* bar = b.bar;
        __builtin_amdgcn_s_waitcnt(0);
        unsigned nloc = b.st[0], nx = b.st[1];
        if (nloc == 0u) { xcd_barrier_complete(bar, b.x, nloc, nx); b.st[0] = nloc; b.st[1] = nx; }
        const unsigned old = xb_add(&bar[XB_XSUB(b.x)], 1u);
        const unsigned gen = old / nloc;
        if (old + 1u == (gen + 1u) * nloc) {
            __builtin_amdgcn_fence(__ATOMIC_RELEASE, "agent");
            asm volatile("s_waitcnt vmcnt(0)" ::: "memory");
            const unsigned og = xb_add(&bar[XB_TOP], 1u);
            const unsigned tg = og / nx;
            if (og + 1u == (tg + 1u) * nx) xb_add(&bar[XB_TOPGEN], 1u);
            else XB_SPIN(xb_ld(&bar[XB_TOPGEN]) == tg, bar);
            __builtin_amdgcn_fence(__ATOMIC_ACQUIRE, "agent");
            xb_add(&bar[XB_XGEN(b.x)], 1u);
            asm volatile("s_waitcnt vmcnt(0)" ::: "memory");
        } else {
            XB_SPIN(xb_ld(&bar[XB_XGEN(b.x)]) == gen, bar);
            __builtin_amdgcn_fence(__ATOMIC_ACQUIRE, "agent");
            asm volatile("s_waitcnt vmcnt(0)" ::: "memory");
        }
    }
    __syncthreads();
}

struct Args { const float* in[20]; float* out; unsigned char* ws; int ph_lo, ph_hi; };
struct Frame {
    LAS unsigned char* lds;
    volatile LAS unsigned* MISC;
    int tid, lane, wave, vcu, G;
    unsigned char* ws; float* sm;
};
#define IN_x         (A.in[0])
#define IN_meta      (A.in[1])
#define IN_norm1_g   (A.in[2])
#define IN_w_in      (A.in[3])
#define IN_q_norm_g  (A.in[4])
#define IN_w_uq      (A.in[5])
#define IN_kv_norm_g (A.in[6])
#define IN_w_ukv     (A.in[7])
#define IN_conv_w    (A.in[8])
#define IN_conv_b    (A.in[9])
#define IN_attn_out_g (A.in[10])
#define IN_conv_out_g (A.in[11])
#define IN_w_out     (A.in[12])
#define IN_norm2_g   (A.in[13])
#define IN_w_query   (A.in[14])
#define IN_keys1     (A.in[15])
#define IN_keys2     (A.in[16])
#define IN_peer_u    (A.in[17])
#define IN_peer_v    (A.in[18])
#define IN_final_g   (A.in[19])
#define WSB(off)     ((bf16*)(F.ws + (off)))
__device__ __forceinline__ void p0_transpose_item(const float* W, int K, int N, const float* g, bf16* WT, LAS float* scr, int item, int lane) {
    const int nblk = N / 32, kb = item / nblk, nb = item % nblk, k0 = 64 * kb, n0 = 32 * nb;
#pragma unroll 8
    for (int i = 0; i < 32; ++i) { const int kk = 2 * i + (lane >> 5); scr[kk * 33 + (lane & 31)] = __builtin_nontemporal_load(W + (size_t)(k0 + kk) * N + n0 + (lane & 31)) * g[k0 + kk]; }
    LDS_WAIT(); asm volatile("" ::: "memory");
    const int c = lane & 7;
#pragma unroll
    for (int j = 0; j < 4; ++j) { const int n = (lane >> 3) + 8 * j; const LAS float* s = scr + (8 * c) * 33 + n;
        v4u o; o.x = pk2(s[0 * 33], s[1 * 33]); o.y = pk2(s[2 * 33], s[3 * 33]); o.z = pk2(s[4 * 33], s[5 * 33]); o.w = pk2(s[6 * 33], s[7 * 33]);
        *(GAS v4u*)(WT + (size_t)(n0 + n) * K + k0 + 8 * c) = o; }
    LDS_WAIT(); asm volatile("" ::: "memory");
}
__device__ __forceinline__ float row_to_bf16(const float* src, const float* gain, bf16* dst, int lane) {
    const GAS f32x4* s4 = (const GAS f32x4*)src;
    f32x4 a0 = s4[2 * lane], a1 = s4[2 * lane + 1], b0 = s4[128 + 2 * lane], b1 = s4[128 + 2 * lane + 1];
    float ss = (a0.x * a0.x + a0.y * a0.y) + (a0.z * a0.z + a0.w * a0.w) + (a1.x * a1.x + a1.y * a1.y) + (a1.z * a1.z + a1.w * a1.w)
             + (b0.x * b0.x + b0.y * b0.y) + (b0.z * b0.z + b0.w * b0.w) + (b1.x * b1.x + b1.y * b1.y) + (b1.z * b1.z + b1.w * b1.w);
    if (gain) { const GAS f32x4* g4 = (const GAS f32x4*)gain; a0 = a0 * g4[2 * lane]; a1 = a1 * g4[2 * lane + 1]; b0 = b0 * g4[128 + 2 * lane]; b1 = b1 * g4[128 + 2 * lane + 1]; }
    v4u o0, o1; o0.x = pk2(a0.x, a0.y); o0.y = pk2(a0.z, a0.w); o0.z = pk2(a1.x, a1.y); o0.w = pk2(a1.z, a1.w);
    o1.x = pk2(b0.x, b0.y); o1.y = pk2(b0.z, b0.w); o1.z = pk2(b1.x, b1.y); o1.w = pk2(b1.z, b1.w);
    GAS v4u* d4 = (GAS v4u*)dst; d4[lane] = o0; d4[64 + lane] = o1;
    return ss;
}
__device__ __forceinline__ void p0_tables(Frame& F, const Args& A, const int which) {
    const int lane = F.lane, gw = F.vcu * NWAVES + F.wave, NGW = F.G * NWAVES;
    if (which == 0) for (int it0 = gw; it0 < NEXP; it0 += 2 * NGW) {
        f32x4 a[2][4]; int ee[2]; bool val[2];
#pragma unroll
        for (int q = 0; q < 2; ++q) {
            const int it = it0 + q * NGW; val[q] = it < NEXP; ee[q] = val[q] ? it : 0;
            const GAS f32x4* s4 = (const GAS f32x4*)(IN_peer_u + (size_t)ee[q] * 1024) + 4 * lane;
#pragma unroll
            for (int j = 0; j < 4; ++j) a[q][j] = __builtin_nontemporal_load(s4 + j);
        }
        const GAS f32x4* g4 = (const GAS f32x4*)IN_norm2_g + 4 * lane;
#pragma unroll
        for (int q = 0; q < 2; ++q) {
            float am = 0.f;
#pragma unroll
            for (int j = 0; j < 4; ++j) { a[q][j] = a[q][j] * g4[j]; am = fmaxf(fmaxf(am, fmaxf(fabsf(a[q][j].x), fabsf(a[q][j].y))), fmaxf(fabsf(a[q][j].z), fabsf(a[q][j].w))); }
            am = wave_max(am);
            v4u o;
            const float inv = am > 0.f ? 127.f / am : 0.f;
#pragma unroll
            for (int j = 0; j < 4; ++j) {
                const unsigned b0 = (unsigned)(int)rintf(a[q][j].x * inv) & 255u, b1 = (unsigned)(int)rintf(a[q][j].y * inv) & 255u;
                const unsigned b2 = (unsigned)(int)rintf(a[q][j].z * inv) & 255u, b3 = (unsigned)(int)rintf(a[q][j].w * inv) & 255u;
                o[j] = b0 | (b1 << 8) | (b2 << 16) | (b3 << 24);
            }
            if (val[q]) {
                __builtin_nontemporal_store(o, (GAS v4u*)(F.ws + WS_U + (size_t)ee[q] * 1024 + 16 * lane));
                if (lane == 0) F.sm[SM_SU + ee[q]] = am * (1.f / 127.f);
            }
        }
    }
    if (which == 1) for (int p0 = gw; p0 < NEXP / 2; p0 += 2 * NGW) {
        f32x4 a[2][8]; bool val[2]; int ee[2];
        const int half = lane >> 5, l31 = lane & 31;
#pragma unroll
        for (int q = 0; q < 2; ++q) {
            const int pr = p0 + q * NGW; val[q] = pr < NEXP / 2; ee[q] = 2 * (val[q] ? pr : 0) + half;
            const GAS f32x4* s4 = (const GAS f32x4*)(IN_peer_v + (size_t)ee[q] * 1024) + l31;
#pragma unroll
            for (int j = 0; j < 8; ++j) a[q][j] = __builtin_nontemporal_load(s4 + 32 * j);
        }
#pragma unroll
        for (int q = 0; q < 2; ++q) {
            float am = 0.f;
#pragma unroll
            for (int j = 0; j < 8; ++j) am = fmaxf(fmaxf(am, fmaxf(fabsf(a[q][j].x), fabsf(a[q][j].y))), fmaxf(fabsf(a[q][j].z), fabsf(a[q][j].w)));
            am = half_max(am);
            const float inv = am > 0.f ? 7.5f / am : 0.f;
            v32h hv;
#pragma unroll
            for (int j = 0; j < 8; ++j) { hv[4 * j] = (_Float16)(a[q][j].x * inv); hv[4 * j + 1] = (_Float16)(a[q][j].y * inv); hv[4 * j + 2] = (_Float16)(a[q][j].z * inv); hv[4 * j + 3] = (_Float16)(a[q][j].w * inv); }
            const v6u pk = __builtin_amdgcn_cvt_scalef32_pk32_fp6_f16(hv, 1.0f);
            if (val[q]) {
                unsigned char* rowp = F.ws + WS_V + (size_t)ee[q] * 768;
                __builtin_nontemporal_store((v4u){pk[0], pk[1], pk[2], pk[3]}, (GAS v4u*)(rowp + 16 * l31)); __builtin_nontemporal_store((v2u){pk[4], pk[5]}, (GAS v2u*)(rowp + 512 + 8 * l31));
                if (l31 == 0) F.sm[SM_SV + ee[q]] = am * (1.f / 7.5f);
            }
        }
    }
}
__device__ __forceinline__ void p0_prologue(Frame& F, const Args& A) {
    const int lane = F.lane, gw = F.vcu * NWAVES + F.wave, NGW = F.G * NWAVES;
    constexpr int PM_ITEMS = 31 * 16;
    if (F.vcu * NWAVES < PM_ITEMS) {
        LAS float* hn = (LAS float*)(F.lds);
#pragma unroll
        for (int rr = 0; rr < 2; ++rr) {
            const int r = 2 * F.wave + rr; float v[16], ss = 0.f;
#pragma unroll
            for (int j = 0; j < 16; ++j) { v[j] = IN_meta[r * 1024 + j * 64 + lane]; ss += v[j] * v[j]; }
            const float rstd = rsqrtf(wave_sum(ss) * (1.f / 1024.f) + EPS);
#pragma unroll
            for (int j = 0; j < 16; ++j) hn[r * 1024 + j * 64 + lane] = v[j] * rstd * IN_norm1_g[j * 64 + lane];
        }
        __syncthreads();
        if (gw < PM_ITEMS) {
            const int cb = gw % 31, kc = gw / 31, col = 64 * cb + lane; const bool ok = col < IN_COLS;
            const float* wp = IN_w_in + (size_t)(64 * kc) * IN_COLS + (ok ? col : 0);
            float acc[16];
#pragma unroll
            for (int r = 0; r < 16; ++r) acc[r] = 0.f;
#pragma unroll 1
            for (int k4 = 0; k4 < 64; k4 += 16) {
                float w[16];
#pragma unroll
                for (int j = 0; j < 16; ++j) w[j] = wp[(size_t)(k4 + j) * IN_COLS];
#pragma unroll
                for (int r = 0; r < 16; ++r) {
#pragma unroll
                    for (int j4 = 0; j4 < 16; j4 += 4) { const f32x4 hv = *(const LAS f32x4*)(hn + r * 1024 + 64 * kc + k4 + j4); acc[r] += (hv.x * w[j4] + hv.y * w[j4 + 1]) + (hv.z * w[j4 + 2] + hv.w * w[j4 + 3]); }
                }
            }
            float* pm = (float*)(F.ws + WS_PMP) + (size_t)kc * (16 * IN_COLS);
            if (ok) {
#pragma unroll
                for (int r = 0; r < 16; ++r) pm[r * IN_COLS + col] = acc[r];
            }
        }
        __syncthreads();
    }
    LAS float* scr = (LAS float*)(F.lds + F.wave * 16384);
    constexpr int I_IN = 16 * 61, I_UQ = 4 * 24, I_UKV = 2 * 32, I_OUT = 16 * 32, I_Q = 16 * 64, NT_ITEMS = I_IN + I_UQ + I_UKV + I_OUT + I_Q;
    for (int it = gw; it < NT_ITEMS; it += NGW) {
        int r = it;
        if (r < I_IN) { p0_transpose_item(IN_w_in, 1024, IN_COLS, IN_norm1_g, WSB(WS_WIN), scr, r, lane); continue; } r -= I_IN;
        if (r < I_UQ) { p0_transpose_item(IN_w_uq, 256, 768, IN_q_norm_g, WSB(WS_WUQ), scr, r, lane); continue; } r -= I_UQ;
        if (r < I_UKV) { p0_transpose_item(IN_w_ukv, 128, 1024, IN_kv_norm_g, WSB(WS_WUKV), scr, r, lane); continue; } r -= I_UKV;
        if (r < I_OUT) { const int kb = r / 32; const float* g = kb < 8 ? IN_attn_out_g : IN_conv_out_g - 512;
                         p0_transpose_item(IN_w_out, 1024, 1024, g, WSB(WS_WOUT), scr, r, lane); continue; } r -= I_OUT;
        p0_transpose_item(IN_w_query, 1024, 2048, IN_norm2_g, WSB(WS_WQ), scr, r, lane);
    }
    for (int it = gw; it < 96; it += NGW) { GAS v4u* d = (GAS v4u*)(WSB(WS_WIN) + (size_t)(IN_COLS + it) * 1024); d[lane] = (v4u){0, 0, 0, 0}; d[64 + lane] = (v4u){0, 0, 0, 0}; }
    for (int it = gw; it < 64; it += NGW) {
        const float* src = (it < 32 ? IN_keys1 : IN_keys2 - 16384) + it * 512 + lane * 8;
        const f32x4 a = *(const GAS f32x4*)src, b = *(const GAS f32x4*)(src + 4);
        v4u o; o.x = pk2(a.x, a.y); o.y = pk2(a.z, a.w); o.z = pk2(b.x, b.y); o.w = pk2(b.z, b.w);
        *(GAS v4u*)(WSB(WS_KEYS) + it * 512 + lane * 8) = o;
    }
    for (int row0 = gw; row0 < M; row0 += 2 * NGW) {
        const int row1 = row0 + NGW; const bool v1 = row1 < M;
        f32x4 xa[2][4];
#pragma unroll
        for (int q = 0; q < 2; ++q) { const GAS f32x4* s4 = (const GAS f32x4*)(IN_x + (size_t)(q == 0 ? row0 : (v1 ? row1 : row0)) * 1024);
            xa[q][0] = __builtin_nontemporal_load(s4 + 2 * lane); xa[q][1] = __builtin_nontemporal_load(s4 + 2 * lane + 1); xa[q][2] = __builtin_nontemporal_load(s4 + 128 + 2 * lane); xa[q][3] = __builtin_nontemporal_load(s4 + 128 + 2 * lane + 1); }
#pragma unroll
        for (int q = 0; q < 2; ++q) {
            float ss = 0.f;
#pragma unroll
            for (int j = 0; j < 4; ++j) ss += (xa[q][j].x * xa[q][j].x + xa[q][j].y * xa[q][j].y) + (xa[q][j].z * xa[q][j].z + xa[q][j].w * xa[q][j].w);
            ss = wave_sum(ss);
            const int row = q == 0 ? row0 : row1;
            if (q == 0 || v1) {
                v4u o0, o1; o0.x = pk2(xa[q][0].x, xa[q][0].y); o0.y = pk2(xa[q][0].z, xa[q][0].w); o0.z = pk2(xa[q][1].x, xa[q][1].y); o0.w = pk2(xa[q][1].z, xa[q][1].w);
                o1.x = pk2(xa[q][2].x, xa[q][2].y); o1.y = pk2(xa[q][2].z, xa[q][2].w); o1.z = pk2(xa[q][3].x, xa[q][3].y); o1.w = pk2(xa[q][3].z, xa[q][3].w);
                GAS v4u* d4 = (GAS v4u*)(WSB(WS_XB) + (size_t)row * 1024); d4[lane] = o0; d4[64 + lane] = o1;
                if (lane == 0) F.sm[SM_RSTD1 + row] = rsqrtf(ss * (1.f / 1024.f) + EPS);
            }
        }
    }
    for (int it = gw * 64 + lane; it < (N_META + SEQ) * 16; it += NGW * 64) {
        const int pos = it >> 4, i = it & 15;
        const float inv = 1.0f / powf(10000.0f, (float)(2 * i) / 32.0f);
        const float ang = (float)pos * inv;
        F.sm[SM_ROPE + pos * 32 + i] = cosf(ang); F.sm[SM_ROPE + pos * 32 + 16 + i] = sinf(ang);
    }
    for (int it = gw; it < BATCH * 48; it += NGW) {
        const int b = it / 48, j = it % 48; const size_t r = (size_t)b * KVROWS + j;
        ((GAS v4u*)(WSB(WS_KN) + r * 512))[lane] = (v4u){0, 0, 0, 0}; ((GAS v4u*)(WSB(WS_VV) + r * 512))[lane] = (v4u){0, 0, 0, 0};
        if (lane < 4) ((GAS v4u*)(WSB(WS_KR) + r * 32))[lane] = (v4u){0, 0, 0, 0};
    }
}

__device__ __forceinline__ float pmeta_sum(const float* pmp, int r, int col) {
    float s = 0.f;
#pragma unroll
    for (int kc = 0; kc < 16; ++kc) s += pmp[(size_t)kc * (16 * IN_COLS) + r * IN_COLS + col];
    return s;
}
__device__ __forceinline__ void p1_meta(Frame& F, const Args& A) {
    const float* pmp = (const float*)(F.ws + WS_PMP);
    if (F.vcu == 32) {
        if (F.tid < 256) {
            const int r = F.tid >> 4, i = F.tid & 15;
            const float c = F.sm[SM_ROPE + r * 32 + i], s = F.sm[SM_ROPE + r * 32 + 16 + i];
            const float x1 = pmeta_sum(pmp, r, O2 + i), x2 = pmeta_sum(pmp, r, O2 + 16 + i);
            const bf16 y1 = (bf16)f2bf(x1 * c - x2 * s), y2 = (bf16)f2bf(x1 * s + x2 * c);
#pragma unroll
            for (int b = 0; b < BATCH; ++b) { const size_t kr = (size_t)b * KVROWS + 48 + r; WSB(WS_KR)[kr * 32 + i] = y1; WSB(WS_KR)[kr * 32 + 16 + i] = y2; }
        }
        for (int idx = F.tid; idx < 1024; idx += 512) { const int i = idx >> 9, c = idx & 511; F.sm[SM_ZMETA + idx] = pmeta_sum(pmp, 14 + i, O4 + c) * pmeta_sum(pmp, 14 + i, O5 + c); }
    }
}
__device__ __forceinline__ void p2_meta_kv(Frame& F, const Args& A, int j) {
    const float* pmp = (const float*)(F.ws + WS_PMP);
    LAS float* st = (LAS float*)F.lds;
    for (int idx = F.tid; idx < 16 * 128; idx += 512) st[idx] = pmeta_sum(pmp, idx >> 7, O1 + (idx & 127));
    __syncthreads();
    if (F.tid < 256) {
        const int r = F.tid >> 4, n = 16 * j + (F.tid & 15);
        const LAS float* ck = st + r * 128;
        float ss = 0.f;
#pragma unroll 16
        for (int k = 0; k < 128; ++k) ss += ck[k] * ck[k];
        const float rstd = rsqrtf(ss * (1.f / 128.f) + EPS);
        float acc = 0.f;
#pragma unroll 32
        for (int k = 0; k < 128; ++k) acc += ck[k] * IN_kv_norm_g[k] * IN_w_ukv[(size_t)k * 1024 + n];
        acc *= rstd;
        const int h = n >> 7, wi = n & 127; const bf16 o = (bf16)f2bf(acc);
#pragma unroll
        for (int b = 0; b < BATCH; ++b) { const size_t kr = (size_t)b * KVROWS + 48 + r; if (wi < 64) WSB(WS_KN)[kr * 512 + h * 64 + wi] = o; else WSB(WS_VV)[kr * 512 + h * 64 + (wi - 64)] = o; }
    }
    __syncthreads();
}

typedef pg8::f32x4 af4;
__device__ __forceinline__ v2u pack4(af4 v) { v2u o; o.x = pg8::cvt_pk_bf16(v[0], v[1]); o.y = pg8::cvt_pk_bf16(v[2], v[3]); return o; }
__device__ __forceinline__ af4 swap32(af4 v) {
    af4 o;
#pragma unroll
    for (int j = 0; j < 4; ++j) { float a = v[j], b = v[j]; asm volatile("s_nop 1\n\tv_permlane32_swap_b32 %0, %1" : "+v"(a), "+v"(b)); o[j] = (lane_id64() & 32) ? a : b; }
    return o;
}
struct EpiInProj {
    static constexpr bool PERM = true, HAS_MID = false; int mid_t;
    bf16* P; const float* rstd1; float* ssqq; float* ssqkv; bf16* KR; const float* rope;
    __device__ __forceinline__ void mid(af4 (&)[2][2][4][2], const pg8::Unit&, int, int, int, int) const {}
    __device__ __forceinline__ void operator()(const af4 (&acc)[2][2][4][2], const pg8::Unit& u, int wr, int wc, int fr, int fq) const {
#pragma unroll
        for (int ai = 0; ai < 2; ++ai)
#pragma unroll
            for (int m = 0; m < 4; ++m) {
                const int row = u.pm * 256 + ai * 128 + wr * 64 + m * 16 + fr; const float rs = rstd1[row];
                float sq = 0.f; af4 v[2][2];
#pragma unroll
                for (int bj = 0; bj < 2; ++bj) {
                    v[bj][0] = acc[ai][bj][m][0] * rs; v[bj][1] = acc[ai][bj][m][1] * rs;
                    const int col = u.pn * 256 + bj * 128 + wc * 32 + 8 * fq;
                    const v2u a = pack4(v[bj][0]), b = pack4(v[bj][1]);
                    *(GAS v4u*)(P + (size_t)row * PN + col) = (v4u){a.x, a.y, b.x, b.y};
                    if (bj == 0 || u.pn == 0) {
#pragma unroll
                        for (int n = 0; n < 2; ++n) sq += (v[bj][n][0] * v[bj][n][0] + v[bj][n][1] * v[bj][n][1]) + (v[bj][n][2] * v[bj][n][2] + v[bj][n][3] * v[bj][n][3]);
                    }
                }
                if (u.pn <= 1) {
                    sq += __shfl_xor(sq, 16); sq += __shfl_xor(sq, 32);
                    if (fq == 0) { if (u.pn == 0) ssqq[row * 4 + wc] = sq; else ssqkv[row * 4 + wc] = sq; }
                }
                if (u.pn == 1 && wc == 0) {
                    const int b = row >> 12, s = row & 4095; const float* rp = rope + (N_META + s) * 32 + 8 * (fq & 1);
                    bf16* kr = KR + ((size_t)b * KVROWS + 64 + s) * 32 + 8 * fq;
#pragma unroll
                    for (int n = 0; n < 2; ++n) {
                        const af4 c = *(const GAS af4*)(rp + 4 * n), sn = *(const GAS af4*)(rp + 16 + 4 * n);
                        const af4 mine = v[1][n], oth = swap32(mine);
                        const af4 y = (fq < 2) ? (mine * c - oth * sn) : (oth * sn + mine * c);
                        *(GAS v2u*)(kr + 4 * n) = pack4(y);
                    }
                }
            }
    }
};
struct EpiKV {
    static constexpr bool PERM = true, HAS_MID = false; int mid_t;
    bf16* KN; bf16* VV; const float* ssqkv;
    __device__ __forceinline__ void mid(af4 (&)[2][2][4][2], const pg8::Unit&, int, int, int, int) const {}
    __device__ __forceinline__ void operator()(const af4 (&acc)[2][2][4][2], const pg8::Unit& u, int wr, int wc, int fr, int fq) const {
        bf16* dst = wc < 2 ? KN : VV;
#pragma unroll
        for (int ai = 0; ai < 2; ++ai)
#pragma unroll
            for (int m = 0; m < 4; ++m) {
                const int row = u.pm * 256 + ai * 128 + wr * 64 + m * 16 + fr;
                const af4 q = *(const GAS af4*)(ssqkv + row * 4);
                const float rs = rsqrtf(((q[0] + q[1]) + (q[2] + q[3])) * (1.f / 128.f) + EPS);
                const size_t kr = (size_t)(row >> 12) * KVROWS + 64 + (row & 4095);
#pragma unroll
                for (int bj = 0; bj < 2; ++bj) {
                    const int h = u.pn * 2 + bj;
                    const af4 v0 = acc[ai][bj][m][0] * rs, v1 = acc[ai][bj][m][1] * rs;
                    const v2u a = pack4(v0), b = pack4(v1);
                    *(GAS v4u*)(dst + kr * 512 + h * 64 + (wc & 1) * 32 + 8 * fq) = (v4u){a.x, a.y, b.x, b.y};
                }
            }
    }
};
struct EpiQ {
    static constexpr bool PERM = false, HAS_MID = false; int mid_t;
    bf16* Q; const float* ssqq; const float* rope;
    __device__ __forceinline__ void mid(af4 (&)[2][2][4][2], const pg8::Unit&, int, int, int, int) const {}
    __device__ __forceinline__ void operator()(const af4 (&acc)[2][2][4][2], const pg8::Unit& u, int wr, int wc, int fr, int fq) const {
#pragma unroll
        for (int ai = 0; ai < 2; ++ai)
#pragma unroll
            for (int m = 0; m < 4; ++m) {
                const int row = u.pm * 256 + ai * 128 + wr * 64 + m * 16 + fr;
                const af4 q = *(const GAS af4*)(ssqq + row * 4);
                const float rs = rsqrtf(((q[0] + q[1]) + (q[2] + q[3])) * (1.f / 256.f) + EPS) * QSCALE;
                const float* rp = rope + (N_META + (row & 4095)) * 32 + 4 * fq;
                const af4 c = *(const GAS af4*)rp, sn = *(const GAS af4*)(rp + 16);
#pragma unroll
                for (int bj = 0; bj < 2; ++bj) {
                    const int g = u.pn * 8 + bj * 4 + wc;
                    af4 v0 = acc[ai][bj][m][0] * rs, v1 = acc[ai][bj][m][1] * rs;
                    if (g % 3 == 2) { const af4 y1 = v0 * c - v1 * sn, y2 = v0 * sn + v1 * c; v0 = y1; v1 = y2; }
                    bf16* qp = Q + (size_t)row * 768 + g * 32 + 4 * fq;
                    *(GAS v2u*)qp = pack4(v0); *(GAS v2u*)(qp + 16) = pack4(v1);
                }
            }
    }
};
struct EpiOut {
    static constexpr bool PERM = true, HAS_MID = true; int mid_t;
    bf16* H2b; float* ssq2; const LAS float* tab;
    __device__ __forceinline__ void mid(af4 (&acc)[2][2][4][2], const pg8::Unit&, int wr, int, int fr, int) const {
#pragma unroll
        for (int ai = 0; ai < 2; ++ai)
#pragma unroll
            for (int m = 0; m < 4; ++m) { const float f = tab[ai * 128 + wr * 64 + m * 16 + fr];
#pragma unroll
                for (int bj = 0; bj < 2; ++bj)
#pragma unroll
                    for (int n = 0; n < 2; ++n) acc[ai][bj][m][n] = acc[ai][bj][m][n] * f; }
    }
    __device__ __forceinline__ void operator()(const af4 (&acc)[2][2][4][2], const pg8::Unit& u, int wr, int wc, int fr, int fq) const {
#pragma unroll
        for (int ai = 0; ai < 2; ++ai)
#pragma unroll
            for (int m = 0; m < 4; ++m) {
                const int row = u.pm * 256 + ai * 128 + wr * 64 + m * 16 + fr; float sq = 0.f;
#pragma unroll
                for (int bj = 0; bj < 2; ++bj) {
                    const int col = u.pn * 256 + bj * 128 + wc * 32 + 8 * fq;
                    const v4u xw = *(const GAS v4u*)(H2b + (size_t)row * 1024 + col);
                    const af4 x0 = {bf_lo(xw.x), bf_hi(xw.x), bf_lo(xw.y), bf_hi(xw.y)}, x1 = {bf_lo(xw.z), bf_hi(xw.z), bf_lo(xw.w), bf_hi(xw.w)};
                    const af4 v0 = acc[ai][bj][m][0] + x0, v1 = acc[ai][bj][m][1] + x1;
                    sq += (v0[0] * v0[0] + v0[1] * v0[1]) + (v0[2] * v0[2] + v0[3] * v0[3]) + (v1[0] * v1[0] + v1[1] * v1[1]) + (v1[2] * v1[2] + v1[3] * v1[3]);
                    const v2u a = pack4(v0), b = pack4(v1);
                    *(GAS v4u*)(H2b + (size_t)row * 1024 + col) = (v4u){a.x, a.y, b.x, b.y};
                }
                sq += __shfl_xor(sq, 16); sq += __shfl_xor(sq, 32);
                if (fq == 0) ssq2[row * 16 + u.pn * 4 + wc] = sq;
            }
    }
};
struct EpiQp {
    static constexpr bool PERM = true, HAS_MID = false; int mid_t;
    bf16* Qp;
    __device__ __forceinline__ void mid(af4 (&)[2][2][4][2], const pg8::Unit&, int, int, int, int) const {}
    __device__ __forceinline__ void operator()(const af4 (&acc)[2][2][4][2], const pg8::Unit& u, int wr, int wc, int fr, int fq) const {
#pragma unroll
        for (int ai = 0; ai < 2; ++ai)
#pragma unroll
            for (int m = 0; m < 4; ++m) {
                const int row = u.pm * 256 + ai * 128 + wr * 64 + m * 16 + fr;
#pragma unroll
                for (int bj = 0; bj < 2; ++bj) {
                    const int col = u.pn * 256 + bj * 128 + wc * 32 + 8 * fq;
                    const v2u a = pack4(acc[ai][bj][m][0]), b = pack4(acc[ai][bj][m][1]);
                    *(GAS v4u*)(Qp + (size_t)row * 2048 + col) = (v4u){a.x, a.y, b.x, b.y};
                }
            }
    }
};

__device__ __forceinline__ void unpack8(v4u w, float (&f)[8]) { f[0] = bf_lo(w.x); f[1] = bf_hi(w.x); f[2] = bf_lo(w.y); f[3] = bf_hi(w.y); f[4] = bf_lo(w.z); f[5] = bf_hi(w.z); f[6] = bf_lo(w.w); f[7] = bf_hi(w.w); }
__device__ __forceinline__ void conv_z(const bf16* prow, int c, float (&z)[8]) {
    float a[8], b[8]; unpack8(*(const GAS v4u*)(prow + O4 + c), a); unpack8(*(const GAS v4u*)(prow + O5 + c), b);
#pragma unroll
    for (int j = 0; j < 8; ++j) z[j] = a[j] * b[j];
}
__device__ __forceinline__ void p2_conv(Frame& F, const Args& A) {
    const int lane = F.lane, gw = F.vcu * NWAVES + F.wave, NGW = F.G * NWAVES, c = 8 * lane;
    float w0[8], w1[8], w2[8], cb[8];
#pragma unroll
    for (int j = 0; j < 8; ++j) { w0[j] = IN_conv_w[c + j]; w1[j] = IN_conv_w[512 + c + j]; w2[j] = IN_conv_w[1024 + c + j]; cb[j] = IN_conv_b[c + j]; }
    for (int ch = gw; ch < M / 8; ch += NGW) {
        const int r0 = ch * 8;
        float z1[8], z2[8];
        if ((r0 & 4095) == 0) {
#pragma unroll
            for (int j = 0; j < 8; ++j) { z2[j] = F.sm[SM_ZMETA + c + j]; z1[j] = F.sm[SM_ZMETA + 512 + c + j]; }
        } else { conv_z(WSB(WS_P) + (size_t)(r0 - 2) * PN, c, z2); conv_z(WSB(WS_P) + (size_t)(r0 - 1) * PN, c, z1); }
        v4u ld_c[8], ld_u[8], ld_b[8];
#pragma unroll
        for (int i = 0; i < 8; ++i) { const bf16* prow = WSB(WS_P) + (size_t)(r0 + i) * PN;
            ld_c[i] = *(const GAS v4u*)(prow + O4 + c); ld_u[i] = *(const GAS v4u*)(prow + O5 + c); ld_b[i] = *(const GAS v4u*)(prow + O3 + c); }
#pragma unroll
        for (int i = 0; i < 8; ++i) {
            const int row = r0 + i;
            float z0[8], bg[8], o[8], ss = 0.f;
            { float a[8], b[8]; unpack8(ld_c[i], a); unpack8(ld_u[i], b);
#pragma unroll
              for (int j = 0; j < 8; ++j) z0[j] = a[j] * b[j]; }
            unpack8(ld_b[i], bg);
#pragma unroll
            for (int j = 0; j < 8; ++j) { o[j] = bg[j] * (cb[j] + w0[j] * z2[j] + w1[j] * z1[j] + w2[j] * z0[j]); ss += o[j] * o[j]; }
            const float rstd = rsqrtf(wave_sum(ss) * (1.f / 512.f) + EPS);
            v4u w; w.x = pk2(o[0] * rstd, o[1] * rstd); w.y = pk2(o[2] * rstd, o[3] * rstd); w.z = pk2(o[4] * rstd, o[5] * rstd); w.w = pk2(o[6] * rstd, o[7] * rstd);
            *(GAS v4u*)(WSB(WS_MIX) + (size_t)row * 1024 + 512 + c) = w;
#pragma unroll
            for (int j = 0; j < 8; ++j) { z2[j] = z1[j]; z1[j] = z0[j]; }
        }
    }
}
__device__ __forceinline__ void p3_attn_simple(Frame& F) {
    LAS float* Qs = (LAS float*)F.lds;
    LAS float* Kt = Qs + 32 * 96;
    LAS float* Vs = Kt + 96 * 65;
    LAS float* Ps = Vs + 64 * 64;
    const bf16 *Q = WSB(WS_Q), *KN = WSB(WS_KN), *VV = WSB(WS_VV), *KR = WSB(WS_KR); bf16* MIX = WSB(WS_MIX); float* ssqatt = F.sm + SM_SSQATT;
    const int tid = F.tid, lane = F.lane, w = F.wave;
    for (int item = F.vcu; item < (SEQ / 32) * 8 * BATCH; item += F.G) {
        const int s0 = (item & 127) * 32, h = (item >> 7) & 7, b = item >> 10;
        const size_t kb = (size_t)b * KVROWS;
        __syncthreads();
        for (int idx = tid; idx < 32 * 96; idx += 512) { const int r = idx / 96, d = idx % 96; Qs[r * 96 + d] = bf2f(Q[((size_t)b * SEQ + s0 + r) * 768 + h * 96 + d]); }
        float m[4], l[4], o[4];
#pragma unroll
        for (int r = 0; r < 4; ++r) { m[r] = -1e30f; l[r] = 0.f; o[r] = 0.f; }
        const int nt = (64 + s0 + 31) / 64 + 1;
        for (int kt = 0; kt < nt; ++kt) {
            const int k0 = kt * 64;
            __syncthreads();
            for (int idx = tid; idx < 64 * 96; idx += 512) {
                const int key = idx / 96, d = idx % 96, kp = k0 + key;
                float v = 0.f;
                if (kp < KVROWS) v = d < 64 ? bf2f(KN[(kb + kp) * 512 + h * 64 + d]) : bf2f(KR[(kb + kp) * 32 + (d - 64)]);
                Kt[d * 65 + key] = v;
            }
            for (int idx = tid; idx < 64 * 64; idx += 512) {
                const int key = idx >> 6, d = idx & 63, kp = k0 + key;
                Vs[key * 64 + d] = kp < KVROWS ? bf2f(VV[(kb + kp) * 512 + h * 64 + d]) : 0.f;
            }
            __syncthreads();
#pragma unroll
            for (int r = 0; r < 4; ++r) {
                const int row = w * 4 + r, sq = s0 + row, kp = k0 + lane;
                const bool vis = (kp >= 48) && (kp <= 64 + sq);
                float s = 0.f;
                for (int d = 0; d < 96; ++d) s += Qs[row * 96 + d] * Kt[d * 65 + lane];
                if (!vis) s = -1e30f;
                const float mn = fmaxf(m[r], wave_max(s));
                const float pv = vis ? exp2f(s - mn) : 0.f;
                const float corr = exp2f(m[r] - mn);
                l[r] = l[r] * corr + wave_sum(pv);
                m[r] = mn;
                Ps[row * 64 + lane] = pv;
                LDS_WAIT();
                float acc = 0.f;
                for (int k = 0; k < 64; ++k) acc += Ps[row * 64 + k] * Vs[k * 64 + lane];
                o[r] = o[r] * corr + acc;
            }
        }
#pragma unroll
        for (int r = 0; r < 4; ++r) {
            const size_t row = (size_t)b * SEQ + s0 + w * 4 + r;
            const float ov = o[r] / l[r];
            MIX[row * 1024 + h * 64 + lane] = (bf16)f2bf(ov);
            const float ss = wave_sum(ov * ov);
            if (lane == 0) ssqatt[row * 8 + h] = ss;
        }
    }
    __syncthreads();
}

__device__ __forceinline__ void wave_argmax(float& v, int& i) {
#pragma unroll
    for (int o = 32; o >= 1; o >>= 1) {
        const float ov = __shfl_xor(v, o); const int oi = __shfl_xor(i, o);
        if (ov > v || (ov == v && oi < i)) { v = ov; i = oi; }
    }
}
__device__ __forceinline__ void top16_of_128(float a0, float a1, int lane, float& tv, int& ti) {
    tv = 0.f; ti = 0;
    for (int k = 0; k < 16; ++k) {
        float bv; int bi;
        if (a0 >= a1) { bv = a0; bi = lane; } else { bv = a1; bi = lane + 64; }
        wave_argmax(bv, bi);
        if (lane == k) { tv = bv; ti = bi; }
        if (bi == lane) a0 = -4e30f;
        if (bi == lane + 64) a1 = -4e30f;
    }
}
__device__ __forceinline__ void p5_topk_simple(Frame& F, const Args& A) {
    const bf16* Qp = WSB(WS_P); const float *keys1 = IN_keys1, *keys2 = IN_keys2, *ssq2 = F.sm + SM_SSQ2; int* IDX = (int*)(F.ws + WS_IDX); float* GATE = (float*)(F.ws + WS_GATE);
    const int lane = F.lane;
    for (int item = F.vcu * NWAVES + F.wave; item < M * 8; item += F.G * NWAVES) {
    const int row = item >> 3, head = item & 7;
    const bf16* q = Qp + (size_t)row * 2048 + head * 256;
    float rs = 0.f;
#pragma unroll
    for (int j = 0; j < 16; ++j) rs += ssq2[row * 16 + j];
    const float rstd = rsqrtf(rs * (1.f / 1024.f) + EPS);
    float s10 = 0.f, s11 = 0.f, s20 = 0.f, s21 = 0.f;
    for (int k = 0; k < 128; ++k) {
        const float q1 = bf2f(q[k]), q2 = bf2f(q[128 + k]);
        s10 += q1 * keys1[lane * 128 + k]; s11 += q1 * keys1[(64 + lane) * 128 + k];
        s20 += q2 * keys2[lane * 128 + k]; s21 += q2 * keys2[(64 + lane) * 128 + k];
    }
    float tv1, tv2; int ti1, ti2;
    top16_of_128(s10 * rstd, s11 * rstd, lane, tv1, ti1);
    top16_of_128(s20 * rstd, s21 * rstd, lane, tv2, ti2);
    const float vb = __shfl(tv2, lane & 15);
    float c0 = __shfl(tv1, (lane >> 4) + 0) + vb, c1 = __shfl(tv1, (lane >> 4) + 4) + vb;
    float c2 = __shfl(tv1, (lane >> 4) + 8) + vb, c3 = __shfl(tv1, (lane >> 4) + 12) + vb;
    float bestv = 0.f; int besti = 0;
    for (int k = 0; k < 16; ++k) {
        float bv = c0; int bi = lane;
        if (c1 > bv) { bv = c1; bi = lane + 64; }
        if (c2 > bv) { bv = c2; bi = lane + 128; }
        if (c3 > bv) { bv = c3; bi = lane + 192; }
        wave_argmax(bv, bi);
        if (lane == k) { bestv = bv; besti = bi; }
        if (bi == lane) c0 = -4e30f;
        if (bi == lane + 64) c1 = -4e30f;
        if (bi == lane + 128) c2 = -4e30f;
        if (bi == lane + 192) c3 = -4e30f;
    }
    const float mx = __shfl(bestv, 0);
    const float e = lane < 16 ? __expf(bestv - mx) : 0.f;
    const float sum = wave_sum(e);
    const int i1 = __shfl(ti1, (besti >> 4) & 15), i2 = __shfl(ti2, besti & 15);
    if (lane < 16) { IDX[(size_t)row * 128 + head * 16 + lane] = i1 * 128 + i2; GATE[(size_t)row * 128 + head * 16 + lane] = e / sum; }
    }
}

__device__ __forceinline__ float gelu_tanh(float x) {
    const float u = 0.7978845608028654f * (x + 0.044715f * x * x * x);
    return 0.5f * x * (1.f + tanhf(u));
}
__device__ __forceinline__ void p6_gather_simple(Frame& F, const Args& A) {
    const bf16 *H2b = WSB(WS_XB), *U = WSB(WS_U), *V = WSB(WS_V); const float *ssq2 = F.sm + SM_SSQ2, *fg = IN_final_g; const int* IDX = (const int*)(F.ws + WS_IDX); const float* GATE = (const float*)(F.ws + WS_GATE); float* out = A.out;
    const int lane = F.lane;
    for (int t = F.vcu * NWAVES + F.wave; t < M; t += F.G * NWAVES) {
    float h2[16], acc[16];
    { float a[8], b[8]; unpack8(*(const GAS v4u*)(H2b + (size_t)t * 1024 + 8 * lane), a); unpack8(*(const GAS v4u*)(H2b + (size_t)t * 1024 + 512 + 8 * lane), b);
#pragma unroll
      for (int j = 0; j < 8; ++j) { h2[j] = a[j]; h2[8 + j] = b[j]; } }
    float rs = 0.f;
#pragma unroll
    for (int j = 0; j < 16; ++j) { rs += ssq2[t * 16 + j]; acc[j] = 0.f; }
    const float rstd = rsqrtf(rs * (1.f / 1024.f) + EPS);
    for (int hk = 0; hk < 128; ++hk) {
        const int e = IDX[(size_t)t * 128 + hk];
        const float g = GATE[(size_t)t * 128 + hk];
        float ua[8], ub[8], va[8], vb[8];
        unpack8(*(const GAS v4u*)(U + (size_t)e * 1024 + 8 * lane), ua); unpack8(*(const GAS v4u*)(U + (size_t)e * 1024 + 512 + 8 * lane), ub);
        unpack8(*(const GAS v4u*)(V + (size_t)e * 1024 + 8 * lane), va); unpack8(*(const GAS v4u*)(V + (size_t)e * 1024 + 512 + 8 * lane), vb);
        float d = 0.f;
#pragma unroll
        for (int j = 0; j < 8; ++j) d += h2[j] * ua[j] + h2[8 + j] * ub[j];
        d = wave_sum(d) * rstd;
        const float coef = g * gelu_tanh(d);
#pragma unroll
        for (int j = 0; j < 8; ++j) { acc[j] += coef * va[j]; acc[8 + j] += coef * vb[j]; }
    }
    float ss = 0.f;
#pragma unroll
    for (int j = 0; j < 16; ++j) { acc[j] += h2[j]; ss += acc[j] * acc[j]; }
    const float r2 = rsqrtf(wave_sum(ss) * (1.f / 1024.f) + EPS);
    const f32x4 g0 = *(const GAS f32x4*)(fg + 8 * lane), g1 = *(const GAS f32x4*)(fg + 8 * lane + 4), g2 = *(const GAS f32x4*)(fg + 512 + 8 * lane), g3 = *(const GAS f32x4*)(fg + 512 + 8 * lane + 4);
    float* o = out + (size_t)t * 1024;
    *(GAS f32x4*)(o + 8 * lane) = (f32x4){acc[0] * r2 * g0.x, acc[1] * r2 * g0.y, acc[2] * r2 * g0.z, acc[3] * r2 * g0.w};
    *(GAS f32x4*)(o + 8 * lane + 4) = (f32x4){acc[4] * r2 * g1.x, acc[5] * r2 * g1.y, acc[6] * r2 * g1.z, acc[7] * r2 * g1.w};
    *(GAS f32x4*)(o + 512 + 8 * lane) = (f32x4){acc[8] * r2 * g2.x, acc[9] * r2 * g2.y, acc[10] * r2 * g2.z, acc[11] * r2 * g2.w};
    *(GAS f32x4*)(o + 512 + 8 * lane + 4) = (f32x4){acc[12] * r2 * g3.x, acc[13] * r2 * g3.y, acc[14] * r2 * g3.z, acc[15] * r2 * g3.w};
    }
}
__device__ __forceinline__ float gelu_fast(float x) {
    const float u = 0.7978845608028654f * (x + 0.044715f * x * x * x);
    const float e = __expf(2.f * u);
    return 0.5f * x * (2.f - 2.f / (e + 1.f));
}
template <int K> __device__ __forceinline__ int xswz(int v) { return __builtin_amdgcn_ds_swizzle(v, (K << 10) | 0x1F); }
__device__ __forceinline__ int sum_xor32(int v) { return v + ix32(v); }
#define G_ISSUE(buf, tbl, ireg, lbase) do { _Pragma("unroll") for (int r_ = 0; r_ < 16; ++r_) { \
        const unsigned e_ = (unsigned)__builtin_amdgcn_readlane((int)(ireg), (lbase) + r_); \
        const unsigned char* rp_ = (tbl) + ((size_t)e_ << 10); asm volatile("" : "+s"(rp_));     \
        buf[r_] = *(const GAS v4u*)(rp_ + voff); } } while (0)
#define G_DOTS(buf, d) do { _Pragma("unroll") for (int r_ = 0; r_ < 16; ++r_) { int s_ = __builtin_amdgcn_sdot4((int)buf[r_].x, hq0, 0, false); \
        s_ = __builtin_amdgcn_sdot4((int)buf[r_].y, hq1, s_, false); s_ = __builtin_amdgcn_sdot4((int)buf[r_].z, hq2, s_, false); d[r_] = __builtin_amdgcn_sdot4((int)buf[r_].w, hq3, s_, false); } } while (0)
#define G_AXW(w, k) do { acc[k] += c_ * (float)((w) & 255u); acc[(k) + 1] += c_ * (float)(((w) >> 8) & 255u); acc[(k) + 2] += c_ * (float)(((w) >> 16) & 255u); acc[(k) + 3] += c_ * (float)((w) >> 24); } while (0)
#define G_AXPY(buf, creg, lbase) do { _Pragma("unroll") for (int r_ = 0; r_ < 16; ++r_) { \
        const float c_ = __builtin_bit_cast(float, __builtin_amdgcn_readlane(__builtin_bit_cast(int, creg), (lbase) + r_)); \
        G_AXW(buf[r_].x, 0); G_AXW(buf[r_].y, 4); G_AXW(buf[r_].z, 8); G_AXW(buf[r_].w, 12); } } while (0)
template <int CTRL> __device__ __forceinline__ int gdpp(int v) { return __builtin_amdgcn_update_dpp(0, v, CTRL, 0xF, 0xF, false); }
__device__ __forceinline__ int gsum_rows(int v) {
    int a = v, b = v; asm volatile("s_nop 1\n\tv_permlane16_swap_b32 %0, %1" : "+v"(a), "+v"(b)); a += b; b = a;
    asm volatile("s_nop 1\n\tv_permlane32_swap_b32 %0, %1" : "+v"(a), "+v"(b)); return a + b;
}
#define G_REDUCE(d, out) do { int e8_[8], e4_[4], e2_[2], e1_; \
        { const bool b_ = lane & 8; _Pragma("unroll") for (int i_ = 0; i_ < 8; ++i_) { const int keep_ = b_ ? d[i_ + 8] : d[i_], send_ = b_ ? d[i_] : d[i_ + 8]; e8_[i_] = keep_ + gdpp<0x128>(send_); } } \
        { const bool b_ = lane & 4; _Pragma("unroll") for (int i_ = 0; i_ < 4; ++i_) { const int keep_ = b_ ? e8_[i_ + 4] : e8_[i_], send_ = b_ ? e8_[i_] : e8_[i_ + 4]; e4_[i_] = keep_ + gdpp<0x141>(send_); } } \
        { const bool b_ = lane & 2; _Pragma("unroll") for (int i_ = 0; i_ < 2; ++i_) { const int keep_ = b_ ? e4_[i_ + 2] : e4_[i_], send_ = b_ ? e4_[i_] : e4_[i_ + 2]; e2_[i_] = keep_ + gdpp<0x4E>(send_); } } \
        { const bool b_ = lane & 1; const int keep_ = b_ ? e2_[1] : e2_[0], send_ = b_ ? e2_[0] : e2_[1]; e1_ = keep_ + gdpp<0xB1>(send_); } \
        out = gsum_rows(e1_); } while (0)
#define G_REDUCE8(d, out) do { int e4_[4], e2_[2], e1_; \
        { const bool b_ = lane & 4; _Pragma("unroll") for (int i_ = 0; i_ < 4; ++i_) { const int keep_ = b_ ? d[i_ + 4] : d[i_], send_ = b_ ? d[i_] : d[i_ + 4]; e4_[i_] = keep_ + gdpp<0x141>(send_); } } \
        { const bool b_ = lane & 2; _Pragma("unroll") for (int i_ = 0; i_ < 2; ++i_) { const int keep_ = b_ ? e4_[i_ + 2] : e4_[i_], send_ = b_ ? e4_[i_] : e4_[i_ + 2]; e2_[i_] = keep_ + gdpp<0x4E>(send_); } } \
        { const bool b_ = lane & 1; const int keep_ = b_ ? e2_[1] : e2_[0], send_ = b_ ? e2_[0] : e2_[1]; e1_ = keep_ + gdpp<0xB1>(send_); } \
        e1_ += gdpp<0x128>(e1_); out = gsum_rows(e1_); } while (0)
#define G_TOUCH16(b) asm volatile("" :: "v"(b[0]), "v"(b[1]), "v"(b[2]), "v"(b[3]), "v"(b[4]), "v"(b[5]), "v"(b[6]), "v"(b[7]), "v"(b[8]), "v"(b[9]), "v"(b[10]), "v"(b[11]), "v"(b[12]), "v"(b[13]), "v"(b[14]), "v"(b[15]))
#define G_TOUCH12(b) asm volatile("" :: "v"(b[0]), "v"(b[1]), "v"(b[2]), "v"(b[3]), "v"(b[4]), "v"(b[5]), "v"(b[6]), "v"(b[7]), "v"(b[8]), "v"(b[9]), "v"(b[10]), "v"(b[11]))
#define GL_SE(ts)   (wl + (ts) * 128)
#define GL_CO(ts)   (wl + 1024 + (ts) * 128)
#define GL_DS(ts)   (wl + 2048 + (ts) * 128)
#define GL_DSC      (wl + 3080)
#define GU_LD1(buf, s_) { const unsigned e_ = (unsigned)__builtin_amdgcn_readlane(ev_, s_);     \
            if constexpr (!(PROBE & 4)) buf[s_] = *(const GAS v4u*)(U + ((e_ << 10) + voff)); }
#define GU_EV(c_, ts_) const int poff_ = __builtin_amdgcn_readlane(offv[ts_], (c_)), pn_ = __builtin_amdgcn_readlane(offv[ts_], (c_) + 1) - poff_; \
        const int ev_ = (wl + ((poff_ + l15) & 127))[(ts_) * 128];
#define GU_ISSUE2(buf) do { const int n_ = pn_; \
        if (n_ >= 8) { _Pragma("unroll") for (int s_ = 0; s_ < 8; ++s_) GU_LD1(buf, s_) _Pragma("unroll") for (int s_ = 8; s_ < 16; ++s_) { if (s_ < n_) GU_LD1(buf, s_) } } \
        else { _Pragma("unroll") for (int s_ = 0; s_ < 8; ++s_) { if (s_ < n_) GU_LD1(buf, s_) } } } while (0)
#define GU_PREP(buf, c_, ts_) do { GU_EV(c_, ts_) GU_ISSUE2(buf); } while (0)
#define GU_STEPM(cur, nxt, cn_, tn_, cc_, tc_) { GU_EV(cn_, tn_) __builtin_amdgcn_sched_barrier(0); G_TOUCH16(cur); __builtin_amdgcn_sched_barrier(0); GU_ISSUE2(nxt); __builtin_amdgcn_sched_barrier(0); \
        GU_COMP(cur, cc_, tc_); __builtin_amdgcn_sched_barrier(0); }
#define GU_DOT16(buf, ts_, d) do { _Pragma("unroll") for (int s_ = 0; s_ < 16; ++s_) { int q_ = __builtin_amdgcn_sdot4((int)buf[s_].x, hq[ts_][0], 0, false); q_ = __builtin_amdgcn_sdot4((int)buf[s_].y, hq[ts_][1], q_, false); \
        q_ = __builtin_amdgcn_sdot4((int)buf[s_].z, hq[ts_][2], q_, false); d[s_] = __builtin_amdgcn_sdot4((int)buf[s_].w, hq[ts_][3], q_, false); } } while (0)
#define GU_DOT8(buf, ts_, d) do { _Pragma("unroll") for (int s_ = 0; s_ < 8; ++s_) { int q_ = __builtin_amdgcn_sdot4((int)buf[s_].x, hq[ts_][0], 0, false); q_ = __builtin_amdgcn_sdot4((int)buf[s_].y, hq[ts_][1], q_, false); \
        q_ = __builtin_amdgcn_sdot4((int)buf[s_].z, hq[ts_][2], q_, false); d[s_] = __builtin_amdgcn_sdot4((int)buf[s_].w, hq[ts_][3], q_, false); } } while (0)
#define GU_COMP(buf, c_, ts_) do { const int off_ = __builtin_amdgcn_readlane(offv[ts_], (c_)), n_ = __builtin_amdgcn_readlane(offv[ts_], (c_) + 1) - off_; \
        int d_[16], r_; if constexpr (!(PROBE & 8)) { if (n_ <= 8) { GU_DOT8(buf, ts_, d_); G_REDUCE8(d_, r_); } else { GU_DOT16(buf, ts_, d_); G_REDUCE(d_, r_); } \
            { LAS int* wt_ = wl + off_ + lane; asm volatile("" : "+v"(wt_)); if (lane < 16 && lane < n_) wt_[2048 + (ts_) * 128] = r_; } } \
        for (int b_ = 16; b_ < n_; b_ += 16) {                                   \
            const int ev2_ = (wl + ((off_ + b_ + l15) & 127))[(ts_) * 128];              \
            _Pragma("unroll") for (int s_ = 0; s_ < 16; ++s_) { if (b_ + s_ < n_) { const unsigned e_ = (unsigned)__builtin_amdgcn_readlane(ev2_, s_); \
                const unsigned char* rp_ = U + ((size_t)e_ << 10); asm volatile("" : "+s"(rp_)); buf[s_] = *(const GAS v4u*)(rp_ + voff); } } \
            GU_DOT16(buf, ts_, d_); G_REDUCE(d_, r_); { LAS int* wt_ = wl + off_ + b_ + lane; asm volatile("" : "+v"(wt_)); if (lane < 16 && b_ + lane < n_) wt_[2048 + (ts_) * 128] = r_; } } } while (0)
#define GV_PAIRS 6
typedef _Float16 gh2 __attribute__((ext_vector_type(2)));
typedef int gv16i __attribute__((ext_vector_type(16)));
#define GV_STEP(c_, ts_) const int off_ = __builtin_amdgcn_readlane(offv[ts_], (c_)), n_ = __builtin_amdgcn_readlane(offv[ts_], (c_) + 1) - off_, h0_ = (n_ + 1) >> 1; \
        const int nvr_ = half ? n_ - h0_ : h0_, nva_ = max(nvr_, 1); const LAS int* sb_ = wl + (ts_) * 128 + off_ + (half ? n_ - nva_ : 0);
#define GV_IDS(E, base_) _Pragma("unroll") for (int q_ = 0; q_ < GV_PAIRS; ++q_) E[q_] = sb_[(base_) + q_];
#define GV_ISSUE(bufa, bufb, E, base_) do { \
        _Pragma("unroll") for (int q_ = 0; q_ < GV_PAIRS; ++q_) { if ((base_) + q_ < h0_) { const unsigned ee_ = (unsigned)((base_) + q_ < nva_ ? E[q_] : E[0]) & 16383u; \
            if constexpr (!(PROBE & 16)) { bufa[q_] = *(const GAS v4u*)(V + (ee_ * 768u + voff6a)); bufb[q_] = *(const GAS v2u*)(V + (ee_ * 768u + voff6b)); } else { bufa[q_].x ^= ee_; } } } } while (0)
#define GV_PREP(bufa, bufb, c_, ts_) do { GV_STEP(c_, ts_) int e_[GV_PAIRS]; GV_IDS(e_, 0) GV_ISSUE(bufa, bufb, e_, 0); } while (0)
#define GV_CWS(CW, base_) _Pragma("unroll") for (int q_ = 0; q_ < GV_PAIRS; ++q_) CW[q_] = sb_[1024 + (base_) + q_];
#define GV_ROWS(bufa, bufb, A_, CW, base_) do { \
        if constexpr (!(PROBE & 32)) _Pragma("unroll") for (int q_ = 0; q_ < GV_PAIRS; ++q_) { if ((base_) + q_ < h0_) { \
            const int cz_ = (base_) + q_ < nvr_ ? CW[q_] : 0; const gh2 c_ = __builtin_bit_cast(gh2, cz_); \
            const v6u pk_ = {bufa[q_].x, bufa[q_].y, bufa[q_].z, bufa[q_].w, bufb[q_].x, bufb[q_].y}; \
            const v32h x_ = __builtin_amdgcn_cvt_scalef32_pk32_f16_fp6(pk_, 1.0f); const gv16i xi_ = __builtin_bit_cast(gv16i, x_); \
            _Pragma("unroll") for (int k_ = 0; k_ < 16; ++k_) { const int xe_ = xi_[k_]; A_[k_] = c_ * __builtin_bit_cast(gh2, xe_) + A_[k_]; } } } } while (0)
#define GV_STEPM(ca, cb, na, nb, cn_, tn_, cc_, tc_, A_) { int e_[GV_PAIRS], cw_[GV_PAIRS]; int nh0_, nnva_; \
        { GV_STEP(cn_, tn_) GV_IDS(e_, 0) nh0_ = h0_; nnva_ = nva_; } \
        { GV_STEP(cc_, tc_) GV_CWS(cw_, 0) \
          __builtin_amdgcn_sched_barrier(0); GV_TOUCH(ca, cb); __builtin_amdgcn_sched_barrier(0); \
          { const int h0_ = nh0_, nva_ = nnva_; GV_ISSUE(na, nb, e_, 0); } __builtin_amdgcn_sched_barrier(0); \
          GV_ROWS(ca, cb, A_, cw_, 0); \
          for (int b_ = GV_PAIRS; b_ < h0_; b_ += GV_PAIRS) {                              \
              int e2_[GV_PAIRS], cw2_[GV_PAIRS]; GV_IDS(e2_, b_) GV_CWS(cw2_, b_) GV_ISSUE(ca, cb, e2_, b_); GV_ROWS(ca, cb, A_, cw2_, b_); } } \
        __builtin_amdgcn_sched_barrier(0); }
#define GV_TOUCH(ba, bb) asm volatile("" :: "v"(ba[0]), "v"(ba[1]), "v"(ba[2]), "v"(ba[3]), "v"(ba[4]), "v"(ba[5]), "v"(bb[0]), "v"(bb[1]), "v"(bb[2]), "v"(bb[3]), "v"(bb[4]), "v"(bb[5]))
#define GV_FINISH(ts_, A_) do { const int t_ = t0 + (ts_); \
        const bf16* hp_ = H2b + (size_t)t_ * 1024; float* op_ = out + (size_t)t_ * 1024; asm volatile("" : "+s"(hp_), "+s"(op_)); \
        gh2 T_[8]; _Pragma("unroll") for (int k_ = 0; k_ < 8; ++k_) { \
            int a_ = __builtin_bit_cast(int, A_[k_]), b_ = a_; asm volatile("s_nop 1\n\tv_permlane32_swap_b32 %0, %1" : "+v"(a_), "+v"(b_)); const gh2 lo_ = __builtin_bit_cast(gh2, a_) + __builtin_bit_cast(gh2, b_); \
            int c_ = __builtin_bit_cast(int, A_[8 + k_]), d_ = c_; asm volatile("s_nop 1\n\tv_permlane32_swap_b32 %0, %1" : "+v"(c_), "+v"(d_)); const gh2 hi_ = __builtin_bit_cast(gh2, c_) + __builtin_bit_cast(gh2, d_); \
            T_[k_] = half ? hi_ : lo_; } \
        float h_[16]; _Pragma("unroll") for (int jr_ = 0; jr_ < 4; ++jr_) { const v2u w_ = *(const GAS v2u*)((const char*)hp_ + eb * 2u + 256 * jr_); \
            h_[4 * jr_] = bf_lo(w_.x) + (float)T_[2 * jr_][0] * (1.f / 256.f); h_[4 * jr_ + 1] = bf_hi(w_.x) + (float)T_[2 * jr_][1] * (1.f / 256.f); \
            h_[4 * jr_ + 2] = bf_lo(w_.y) + (float)T_[2 * jr_ + 1][0] * (1.f / 256.f); h_[4 * jr_ + 3] = bf_hi(w_.y) + (float)T_[2 * jr_ + 1][1] * (1.f / 256.f); } \
        float ss_ = 0.f; _Pragma("unroll") for (int j_ = 0; j_ < 16; ++j_) ss_ += h_[j_] * h_[j_]; \
        const float r2_ = rsqrtf(wave_sum(ss_) * (1.f / 1024.f) + EPS); \
        _Pragma("unroll") for (int jr_ = 0; jr_ < 4; ++jr_) { const f32x4 g_ = *(const GAS f32x4*)((const char*)fg + eb * 4u + 512 * jr_); \
            const f32x4 ov_ = (f32x4){h_[4 * jr_] * r2_ * g_.x, h_[4 * jr_ + 1] * r2_ * g_.y, h_[4 * jr_ + 2] * r2_ * g_.z, h_[4 * jr_ + 3] * r2_ * g_.w}; \
            if (PROBE == 0 || ov_.x == 12345.678f) __builtin_nontemporal_store(ov_, (GAS f32x4*)((char*)op_ + eb * 4u + 512 * jr_)); } } while (0)
template <int PROBE> __device__ __forceinline__ void p6_gather(Frame& F, const Args& A) {
    const bf16* H2b = WSB(WS_XB); const unsigned char *U = F.ws + WS_U, *V = F.ws + WS_V;
    const float *ssq2 = F.sm + SM_SSQ2, *SU = F.sm + SM_SU, *SV = F.sm + SM_SV, *fg = IN_final_g; const int* IDX = (const int*)(F.ws + WS_IDX); const float* GATE = (const float*)(F.ws + WS_GATE); float* out = A.out;
    const int lane = F.lane, l15 = lane & 15, half = lane >> 5, gw = F.vcu * NWAVES + F.wave, NGW = F.G * NWAVES; const unsigned voff = (unsigned)lane * 16u;
    const unsigned voff6a = (unsigned)(lane & 31) * 16u, voff6b = 512u + (unsigned)(lane & 31) * 8u, eb = 512u * (unsigned)half + 4u * (unsigned)(lane & 31);
    LAS int* wl = (LAS int*)(F.lds + F.wave * 12544);
    LAS int* wll = wl + lane; asm volatile("" : "+v"(wll));
    for (int tb = gw; tb < M / 8; tb += NGW) {
        const int t0 = tb * 8;
        int hq[8][4], offv[8];
#pragma unroll
        for (int ts = 0; ts < 8; ++ts) {
            const int t = t0 + ts;
            const int* ip_ = IDX + (size_t)t * 128; const float* gp_ = GATE + (size_t)t * 128; const bf16* hp_ = H2b + (size_t)t * 1024; const float* sp_ = ssq2 + (size_t)t * 16;
            asm volatile("" : "+s"(ip_), "+s"(gp_), "+s"(hp_), "+s"(sp_));
            const unsigned l4 = voff >> 2;
            const int i0 = __builtin_nontemporal_load((const GAS int*)((const char*)ip_ + l4)), i1 = __builtin_nontemporal_load((const GAS int*)((const char*)ip_ + l4 + 256));
            const float gt0 = __builtin_nontemporal_load((const GAS float*)((const char*)gp_ + l4)), gt1 = __builtin_nontemporal_load((const GAS float*)((const char*)gp_ + l4 + 256));
            const v4u ha = *(const GAS v4u*)((const char*)hp_ + voff * 2u), hb = *(const GAS v4u*)((const char*)hp_ + voff * 2u + 16);
            float rs = lane < 16 ? *(const GAS float*)((const char*)sp_ + l4) : 0.f;
            rs = wave_sum(rs);
            float h[16]; { float a8[8], b8[8]; unpack8(ha, a8); unpack8(hb, b8);
#pragma unroll
                for (int j = 0; j < 8; ++j) { h[j] = a8[j]; h[8 + j] = b8[j]; } }
            float am = 0.f;
#pragma unroll
            for (int j = 0; j < 16; ++j) am = fmaxf(am, fabsf(h[j]));
            am = wave_max(am); const float inv = am > 0.f ? 127.f / am : 0.f;
            if (lane == 0) GL_DSC[ts] = __builtin_bit_cast(int, am * (1.f / 127.f) * rsqrtf(rs * (1.f / 1024.f) + EPS));
#pragma unroll
            for (int j = 0; j < 4; ++j) hq[ts][j] = (int)(((unsigned)(int)rintf(h[4 * j] * inv) & 255u) | (((unsigned)(int)rintf(h[4 * j + 1] * inv) & 255u) << 8) | (((unsigned)(int)rintf(h[4 * j + 2] * inv) & 255u) << 16) | (((unsigned)(int)rintf(h[4 * j + 3] * inv) & 255u) << 24));
            const int k0 = i0 >> 10, k1 = i1 >> 10; int p0 = 0, p1 = 0, run = 0, ov = 0;
#pragma unroll
            for (int c = 0; c < 16; ++c) {
                const unsigned long long m0 = __ballot(k0 == c), m1 = __ballot(k1 == c);
                const int c0 = __builtin_popcountll(m0), c1 = __builtin_popcountll(m1);
                const int b0 = (int)__builtin_amdgcn_mbcnt_hi((unsigned)(m0 >> 32), __builtin_amdgcn_mbcnt_lo((unsigned)m0, 0u));
                const int b1 = (int)__builtin_amdgcn_mbcnt_hi((unsigned)(m1 >> 32), __builtin_amdgcn_mbcnt_lo((unsigned)m1, 0u));
                p0 = (k0 == c) ? run + b0 : p0; p1 = (k1 == c) ? run + c0 + b1 : p1;
                asm volatile("s_nop 1\n\tv_writelane_b32 %0, %1, %2" : "+v"(ov) : "s"(run), "n"(c));
                run += c0 + c1;
            }
            { const int e128 = 128; asm volatile("s_nop 1\n\tv_writelane_b32 %0, %1, 16" : "+v"(ov) : "s"(e128)); }
            offv[ts] = ov;
            { LAS int* w0 = wl + p0; LAS int* w1 = wl + p1; w0[ts * 128] = i0; w1[ts * 128] = i1; w0[1024 + ts * 128] = __builtin_bit_cast(int, gt0); w1[1024 + ts * 128] = __builtin_bit_cast(int, gt1); }
        }
        if constexpr (!(PROBE & 2)) {
            v4u bX[16], bY[16];
#pragma unroll
            for (int j = 0; j < 16; ++j) { bX[j] = (v4u){0u, 0u, 0u, 0u}; bY[j] = (v4u){0u, 0u, 0u, 0u}; }
            GU_PREP(bX, 0, 0);
#pragma unroll 1
            for (int c = 0; c < 16; ++c) {
                const int cn = c < 15 ? c + 1 : c;
                GU_STEPM(bX, bY, c, 1, c, 0)
                GU_STEPM(bY, bX, c, 2, c, 1)
                GU_STEPM(bX, bY, c, 3, c, 2)
                GU_STEPM(bY, bX, c, 4, c, 3)
                GU_STEPM(bX, bY, c, 5, c, 4)
                GU_STEPM(bY, bX, c, 6, c, 5)
                GU_STEPM(bX, bY, c, 7, c, 6)
                GU_STEPM(bY, bX, cn, 0, c, 7)
            }
        }
#pragma unroll
        for (int ts = 0; ts < 8; ++ts) {
            const int e0 = wll[(ts) * 128], e1 = wll[(ts) * 128 + 64];
            const float gt0 = __builtin_bit_cast(float, wll[1024 + (ts) * 128]), gt1 = __builtin_bit_cast(float, wll[1024 + (ts) * 128 + 64]);
            const int d0 = wll[2048 + (ts) * 128], d1 = wll[2048 + (ts) * 128 + 64];
            const float su0 = SU[e0], su1 = SU[e1], sv0 = SV[e0], sv1 = SV[e1], dsc_ = __builtin_bit_cast(float, GL_DSC[ts]);
            const float coef0 = gt0 * gelu_fast((float)d0 * su0 * dsc_) * sv0, coef1 = gt1 * gelu_fast((float)d1 * su1 * dsc_) * sv1;
            { const _Float16 c0h = (_Float16)(coef0 * 256.f), c1h = (_Float16)(coef1 * 256.f);
              wll[1024 + (ts) * 128] = __builtin_bit_cast(int, (gh2){c0h, c0h}); wll[1024 + (ts) * 128 + 64] = __builtin_bit_cast(int, (gh2){c1h, c1h}); }
        }
#pragma unroll 1
        for (int sp = (PROBE & 1) ? 2 : 0; sp < 2; ++sp) {
            gh2 a0[16], a1[16], a2[16], a3[16];
#pragma unroll
            for (int j = 0; j < 16; ++j) { a0[j] = (gh2){0, 0}; a1[j] = (gh2){0, 0}; a2[j] = (gh2){0, 0}; a3[j] = (gh2){0, 0}; }
            v4u bX[GV_PAIRS], bY[GV_PAIRS]; v2u cX[GV_PAIRS], cY[GV_PAIRS];
#pragma unroll
            for (int j = 0; j < GV_PAIRS; ++j) { bX[j] = (v4u){0u, 0u, 0u, 0u}; bY[j] = (v4u){0u, 0u, 0u, 0u}; cX[j] = (v2u){0u, 0u}; cY[j] = (v2u){0u, 0u}; }
            if (sp == 0) {
                GV_PREP(bX, cX, 0, 0);
#pragma unroll 1
                for (int c = 0; c < 16; ++c) {
                    const int cn = c < 15 ? c + 1 : c;
                    GV_STEPM(bX, cX, bY, cY, c, 1, c, 0, a0)
                    GV_STEPM(bY, cY, bX, cX, c, 2, c, 1, a1)
                    GV_STEPM(bX, cX, bY, cY, c, 3, c, 2, a2)
                    GV_STEPM(bY, cY, bX, cX, cn, 0, c, 3, a3)
                }
                GV_FINISH(0, a0); GV_FINISH(1, a1); GV_FINISH(2, a2); GV_FINISH(3, a3);
            } else {
                GV_PREP(bX, cX, 0, 4);
#pragma unroll 1
                for (int c = 0; c < 16; ++c) {
                    const int cn = c < 15 ? c + 1 : c;
                    GV_STEPM(bX, cX, bY, cY, c, 5, c, 4, a0)
                    GV_STEPM(bY, cY, bX, cX, c, 6, c, 5, a1)
                    GV_STEPM(bX, cX, bY, cY, c, 7, c, 6, a2)
                    GV_STEPM(bY, cY, bX, cX, cn, 4, c, 7, a3)
                }
                GV_FINISH(4, a0); GV_FINISH(5, a1); GV_FINISH(6, a2); GV_FINISH(7, a3);
            }
        }
    }
}
typedef short tk_bf16x8 __attribute__((ext_vector_type(8)));
typedef float tk_f32x16 __attribute__((ext_vector_type(16)));
__device__ __forceinline__ void tk_ins16(float (&t)[16], float x) {
#pragma unroll
    for (int j = 15; j >= 1; --j) t[j] = __builtin_amdgcn_fmed3f(t[j - 1], t[j], x);
    t[0] = __builtin_fmaxf(t[0], x);
}
__device__ __forceinline__ void tk_sort_bitonic16(float (&c)[16]) {
#pragma unroll
    for (int st = 8; st >= 1; st >>= 1)
#pragma unroll
        for (int i = 0; i < 16; ++i) if ((i & st) == 0) { const float hi = __builtin_fmaxf(c[i], c[i + st]), lo = __builtin_fminf(c[i], c[i + st]); c[i] = hi; c[i + st] = lo; }
}
__device__ __forceinline__ void tk_merge_pair(float (&t)[16]) {
    float b[16];
#pragma unroll
    for (int i = 0; i < 16; ++i) b[i] = __shfl_xor(t[i], 32);
#pragma unroll
    for (int i = 0; i < 16; ++i) t[i] = __builtin_fmaxf(t[i], b[15 - i]);
    tk_sort_bitonic16(t);
}
template <int PROBE> __device__ __forceinline__ void tk_side(const LAS unsigned char* klds, const bf16* keys, const bf16* qrow, int lane, float (&t)[16]) {
    const int r32 = lane & 31, h = lane >> 5;
    tk_f32x16 acc[4];
#ifdef TK_EXPERIMENT_VALU
#pragma unroll
    for (int mt = 0; mt < 4; ++mt)
#pragma unroll
        for (int r = 0; r < 16; ++r) {
            const int key = 32 * mt + (r & 3) + 8 * (r >> 2) + 4 * h; float s = 0.f;
            for (int k = 0; k < 128; ++k) s += bf2f(qrow[k]) * bf2f(keys[key * 128 + k]);
            acc[mt][r] = s;
        }
#else
    tk_bf16x8 qf[8];
#pragma unroll
    for (int ks = 0; ks < 8; ++ks) qf[ks] = *(const GAS tk_bf16x8*)(qrow + 16 * ks + 8 * h);
#pragma unroll
    for (int mt = 0; mt < 4; ++mt) {
        acc[mt] = (tk_f32x16){0.f, 0.f, 0.f, 0.f, 0.f, 0.f, 0.f, 0.f, 0.f, 0.f, 0.f, 0.f, 0.f, 0.f, 0.f, 0.f};
        const int row = 32 * mt + r32;
        const LAS unsigned char* kp = klds + row * 256;
#pragma unroll
        for (int ks = 0; ks < 8; ++ks) {
            const tk_bf16x8 kf = *(const LAS tk_bf16x8*)(kp + (((2 * ks + h) ^ (row & 15)) << 4));
            acc[mt] = __builtin_amdgcn_mfma_f32_32x32x16_bf16(kf, qf[ks], acc[mt], 0, 0, 0);
        }
    }
#endif
#pragma unroll
    for (int j = 0; j < 16; ++j) t[j] = -3.0e38f;
    const unsigned h4 = (unsigned)h << 2;
#pragma unroll
    for (int mt = 0; mt < 4; ++mt)
#pragma unroll
        for (int r = 0; r < 16; ++r) {
            const unsigned key = (unsigned)(32 * mt + (r & 3) + 8 * (r >> 2)) | h4;
            const float av = acc[mt][r];
            const float x = __builtin_bit_cast(float, (__builtin_bit_cast(unsigned, av) & ~127u) | key);
            if constexpr (!(PROBE & 256)) tk_ins16(t, x); else t[r] = __builtin_fmaxf(t[r], x);
        }
    tk_merge_pair(t);
}
template <int PROBE> __device__ __forceinline__ void p5_topk(Frame& F, const Args& A, const pg8::StaticOrder& S) {
    const bf16 *Qp = WSB(WS_P), *Keys = WSB(WS_KEYS); const float* ssq2 = F.sm + SM_SSQ2; int* IDX = (int*)(F.ws + WS_IDX); float* GATE = (float*)(F.ws + WS_GATE);
    const int lane = F.lane, h = lane >> 5;
    for (int c = F.tid; c < 4096; c += NWAVES * 64) {
        const int row = (c >> 4) & 127, ch = c & 15;
        const v4u v = *(const GAS v4u*)(Keys + (size_t)c * 8);
        *(LAS v4u*)(F.lds + (c >> 11) * 32768 + row * 256 + ((ch ^ (row & 15)) << 4)) = v;
    }
    __syncthreads();
    pg8::Unit u;
    for (int i = 0; S.next(i, u); ++i) {
        const int row = u.pm * 256 + 32 * F.wave + (lane & 31), head = u.pn;
        const bf16* qrow = Qp + (size_t)row * 2048 + head * 256;
        float v1[16], v2[16];
        tk_side<PROBE>(F.lds, Keys, qrow, lane, v1);
        __builtin_amdgcn_sched_barrier(0);
        tk_side<PROBE>(F.lds + 32768, Keys + 16384, qrow + 128, lane, v2);
        __builtin_amdgcn_sched_barrier(0);
        if constexpr (PROBE & 128) { if (v1[0] + v2[0] == 12345.678f) IDX[row] = 1; continue; }
        float rs = 0.f;
        { const f32x4 a = *(const GAS f32x4*)(ssq2 + row * 16), b = *(const GAS f32x4*)(ssq2 + row * 16 + 4), c = *(const GAS f32x4*)(ssq2 + row * 16 + 8), d = *(const GAS f32x4*)(ssq2 + row * 16 + 12);
          rs = ((a.x + a.y) + (a.z + a.w)) + ((b.x + b.y) + (b.z + b.w)) + ((c.x + c.y) + (c.z + c.w)) + ((d.x + d.y) + (d.z + d.w)); }
        const float rs2l = rsqrtf(rs * (1.f / 1024.f) + EPS) * 1.4426950408889634f;
        unsigned k1m[16], k2m[16];
#pragma unroll
        for (int j = 0; j < 16; ++j) { k1m[j] = (__builtin_bit_cast(unsigned, v1[j]) & 127u) << 7; k2m[j] = __builtin_bit_cast(unsigned, v2[j]) & 127u; }
        float t[16];
#pragma unroll
        for (int j = 0; j < 16; ++j) t[j] = -3.0e38f;
#define TK_X(i, ae, be, ao, bo) const float s_ = (h ? v1[ao] : v1[ae]) + (h ? v2[bo] : v2[be]); \
            const float x_ = __builtin_bit_cast(float, (__builtin_bit_cast(unsigned, s_) & ~63u) | (unsigned)(2 * (i)) | (unsigned)h);
#define TK_CAND(i, ae, be, ao, bo) { TK_X(i, ae, be, ao, bo) tk_ins16(t, x_); }
    TK_CAND(0, 0, 0, 0, 1)
    TK_CAND(1, 0, 2, 0, 3)
    TK_CAND(2, 0, 4, 0, 5)
    TK_CAND(3, 0, 6, 0, 7)
    TK_CAND(4, 0, 8, 0, 9)
    TK_CAND(5, 0, 10, 0, 11)
    TK_CAND(6, 0, 12, 0, 13)
    TK_CAND(7, 0, 14, 0, 15)
    TK_CAND(8, 1, 0, 1, 1)
    TK_CAND(9, 1, 2, 1, 3)
    TK_CAND(10, 1, 4, 1, 5)
    TK_CAND(11, 1, 6, 1, 7)
    TK_CAND(12, 2, 0, 2, 1)
    TK_CAND(13, 2, 2, 2, 3)
    TK_CAND(14, 2, 4, 3, 0)
    TK_CAND(15, 3, 1, 3, 2)
    TK_CAND(16, 3, 3, 4, 0)
    TK_CAND(17, 4, 1, 4, 2)
    TK_CAND(18, 5, 0, 5, 1)
    TK_CAND(19, 6, 0, 6, 1)
    TK_CAND(20, 7, 0, 7, 1)
    TK_CAND(21, 8, 0, 9, 0)
    TK_CAND(22, 10, 0, 11, 0)
    TK_CAND(23, 12, 0, 13, 0)
    TK_CAND(24, 14, 0, 15, 0)
#undef TK_CAND
        tk_merge_pair(t);
        __builtin_amdgcn_sched_barrier(0);
        float den = 0.f;
#pragma unroll
        for (int j = 0; j < 16; ++j) den += __builtin_amdgcn_exp2f((t[j] - t[0]) * rs2l);
        const float inv = 1.f / den, thr = t[15], top = t[0];
        int pos = h ? 15 : 0; const int step = h ? -1 : 1;
        int* ip = IDX + (size_t)row * 128 + head * 16; float* gp = GATE + (size_t)row * 128 + head * 16;
#define TK_CAND(i, ae, be, ao, bo) { TK_X(i, ae, be, ao, bo) const bool sel = x_ >= thr; \
            if (sel) { ip[pos] = (int)((h ? k1m[ao] : k1m[ae]) | (h ? k2m[bo] : k2m[be])); gp[pos] = __builtin_amdgcn_exp2f((x_ - top) * rs2l) * inv; } \
            pos += sel ? step : 0; }
    TK_CAND(0, 0, 0, 0, 1)
    TK_CAND(1, 0, 2, 0, 3)
    TK_CAND(2, 0, 4, 0, 5)
    TK_CAND(3, 0, 6, 0, 7)
    TK_CAND(4, 0, 8, 0, 9)
    TK_CAND(5, 0, 10, 0, 11)
    TK_CAND(6, 0, 12, 0, 13)
    TK_CAND(7, 0, 14, 0, 15)
    TK_CAND(8, 1, 0, 1, 1)
    TK_CAND(9, 1, 2, 1, 3)
    TK_CAND(10, 1, 4, 1, 5)
    TK_CAND(11, 1, 6, 1, 7)
    TK_CAND(12, 2, 0, 2, 1)
    TK_CAND(13, 2, 2, 2, 3)
    TK_CAND(14, 2, 4, 3, 0)
    TK_CAND(15, 3, 1, 3, 2)
    TK_CAND(16, 3, 3, 4, 0)
    TK_CAND(17, 4, 1, 4, 2)
    TK_CAND(18, 5, 0, 5, 1)
    TK_CAND(19, 6, 0, 6, 1)
    TK_CAND(20, 7, 0, 7, 1)
    TK_CAND(21, 8, 0, 9, 0)
    TK_CAND(22, 10, 0, 11, 0)
    TK_CAND(23, 12, 0, 13, 0)
    TK_CAND(24, 14, 0, 15, 0)
#undef TK_CAND
#undef TK_X
    }
}
namespace att {
typedef short bf16x8 __attribute__((ext_vector_type(8)));
typedef short s16x4 __attribute__((ext_vector_type(4)));
typedef float f32x16 __attribute__((ext_vector_type(16)));
constexpr int KT = 12288, VT = 8192, SLOT = KT + VT;
constexpr int WSF_OFF = 2 * SLOT, OST_OFF = WSF_OFF + NWAVES * 256, LDS_NEED = OST_OFF + NWAVES * 4096;
static_assert(LDS_NEED <= RING_BYTES, "attention LDS");
constexpr float NEG = -1.0e30f;
__device__ __forceinline__ int crow(int r, int hi) { return (r & 3) + 8 * (r >> 2) + 4 * hi; }
__device__ __forceinline__ unsigned cvtpk(float lo, float hi) { typedef float f2 __attribute__((ext_vector_type(2))); typedef __bf16 b2 __attribute__((ext_vector_type(2))); f2 v = {lo, hi}; b2 b = __builtin_convertvector(v, b2); return __builtin_bit_cast(unsigned, b); }
__device__ __forceinline__ s16x4 vtr(const LAS unsigned char* p) { typedef short v4i16_t __attribute__((ext_vector_type(4))); return __builtin_bit_cast(s16x4, __builtin_amdgcn_ds_read_tr16_b64_v4i16((LAS v4i16_t*)p)); }
__device__ __forceinline__ float max3f(float a, float b, float c) { float r; asm("v_max3_f32 %0, %1, %2, %3" : "=v"(r) : "v"(a), "v"(b), "v"(c)); return r; }
__device__ __forceinline__ float max2f(float a, float b) { float r; asm("v_max_f32_e32 %0, %1, %2" : "=v"(r) : "v"(a), "v"(b)); return r; }
__device__ __forceinline__ void glds16(const void* g, LAS unsigned char* l) { __builtin_amdgcn_global_load_lds((const unsigned*)g, (LAS unsigned*)l, 16, 0, 0); }

template <int PROBE> __device__ __forceinline__ void attn_unit(LAS unsigned char* lds, int b, int h, int qb, const bf16* Q, const bf16* KN, const bf16* VV, const bf16* KR, bf16* MIX, float* ssqatt, int wave, int lane) {
    const int r32 = lane & 31, hi = lane >> 5;
    const size_t kb = (size_t)b * KVROWS;
    const int NT = 4 * qb + 5;
    const int row0 = b * SEQ + qb * 256 + wave * 32;
    const int qrel = wave * 32 + r32;
    bf16x8 qf[6];
    { const bf16* qp = Q + (size_t)(row0 + r32) * 768 + h * 96 + 8 * hi;
#pragma unroll
      for (int ks = 0; ks < 6; ++ks) qf[ks] = *(const GAS bf16x8*)(qp + 16 * ks); }
    const bf16* ksrc0 = KN + (kb + lane) * 512 + h * 64 + wave * 8;
    const bf16* ksrc1 = KR + (kb + lane) * 32 + (wave & 3) * 8;
    const bf16* vsrc = VV + (kb + 16 * (wave & 3) + (lane >> 2)) * 512 + h * 64 + (wave >> 2) * 32 + (lane & 3) * 8;
#define ATT_DMA(t, slot) do { LAS unsigned char* s_ = lds + (slot) * SLOT; glds16(ksrc0 + (size_t)(t) * (64 * 512), s_ + wave * 1024); \
        if (wave < 4) glds16(ksrc1 + (size_t)(t) * (64 * 32), s_ + (8 + wave) * 1024); glds16(vsrc + (size_t)(t) * (64 * 512), s_ + KT + wave * 1024); } while (0)
    LAS float* wsf = (LAS float*)(lds + WSF_OFF + wave * 256);
    const int kfo = hi * 1024 + r32 * 16;
    const int vfo = ((lane >> 4) & 1) * 32 + (lane & 3) * 8 + (4 * hi + ((lane & 15) >> 2)) * 64;
    constexpr float THR = 8.0f;
    float m = 0.f;
    f32x16 o0, o1, o2, negm;
#pragma unroll
    for (int r = 0; r < 16; ++r) { o0[r] = 0.f; o1[r] = 0.f; o2[r] = 0.f; negm[r] = 0.f; }
    const bf16x8 ones = {0x3F80, 0x3F80, 0x3F80, 0x3F80, 0x3F80, 0x3F80, 0x3F80, 0x3F80};
    ATT_DMA(0, 0);
    for (int t = 0; t < NT; ++t) {
        asm volatile("s_waitcnt vmcnt(0)" ::: "memory"); __builtin_amdgcn_s_barrier(); asm volatile("" ::: "memory");
        if (t + 1 < NT) { if constexpr (!(PROBE & 32)) ATT_DMA(t + 1, (t + 1) & 1); }
        const int jb = t - (NT - 4);
        if constexpr (PROBE & 512) { if (wave >= 4) continue; }
        if (jb >= 1 && 64 * jb > wave * 32 + 31) continue;
        const LAS unsigned char* kbuf = lds + (t & 1) * SLOT; const LAS unsigned char* vbuf = kbuf + KT;
        f32x16 p0, p1;
        p0 = negm; p1 = negm;
        if constexpr (!(PROBE & 16)) {
        { const bf16x8 a0 = *(const LAS bf16x8*)(kbuf + kfo), a1 = *(const LAS bf16x8*)(kbuf + kfo + 512);
          p0 = __builtin_amdgcn_mfma_f32_32x32x16_bf16(a0, qf[0], negm, 0, 0, 0); p1 = __builtin_amdgcn_mfma_f32_32x32x16_bf16(a1, qf[0], negm, 0, 0, 0); }
#pragma unroll
        for (int ks = 1; ks < 6; ++ks) {
            const bf16x8 a0 = *(const LAS bf16x8*)(kbuf + ks * 2048 + kfo), a1 = *(const LAS bf16x8*)(kbuf + ks * 2048 + kfo + 512);
            p0 = __builtin_amdgcn_mfma_f32_32x32x16_bf16(a0, qf[ks], p0, 0, 0, 0);
            p1 = __builtin_amdgcn_mfma_f32_32x32x16_bf16(a1, qf[ks], p1, 0, 0, 0);
        }
        }
        if (t == 0) {
#pragma unroll
            for (int r = 0; r < 16; ++r) p0[r] = NEG;
#pragma unroll
            for (int r = 0; r < 8; ++r) p1[r] = NEG;
        }
        if (jb >= 0) {
#pragma unroll
            for (int r = 0; r < 16; ++r) { const int kv = 64 * jb + crow(r, hi); if (kv > qrel) p0[r] = NEG; if (kv + 32 > qrel) p1[r] = NEG; }
        }
        float mx;
        { float a = max3f(p0[0], p0[1], p1[0]), b = max3f(p0[2], p0[3], p1[1]); a = max3f(a, p1[2], p1[3]);
#pragma unroll
          for (int r = 4; r < 16; r += 4) { a = max3f(a, p0[r], p0[r + 1]); b = max3f(b, p0[r + 2], p0[r + 3]); a = max3f(a, p1[r], p1[r + 1]); b = max3f(b, p1[r + 2], p1[r + 3]); }
          float ma = max2f(a, b), mb = ma;
          asm volatile("s_nop 1\n\tv_permlane32_swap_b32 %0, %1" : "+v"(ma), "+v"(mb)); mx = max2f(ma, mb); }
        if (__builtin_expect(__any(mx > THR), 0)) {
            const float dl = __builtin_fmaxf(mx, 0.f), f = __builtin_amdgcn_exp2f(-dl);
            m += dl;
#pragma unroll
            for (int r = 0; r < 16; ++r) { p0[r] -= dl; p1[r] -= dl; negm[r] = -m; }
            if (hi == 0) wsf[r32] = f;
            asm volatile("s_waitcnt lgkmcnt(0)" ::: "memory");
#pragma unroll
            for (int g = 0; g < 4; ++g) { const f32x4 a4 = *(const LAS f32x4*)(wsf + 8 * g + 4 * hi);
#pragma unroll
                for (int j = 0; j < 4; ++j) { o0[4 * g + j] *= a4[j]; o1[4 * g + j] *= a4[j]; o2[4 * g + j] *= a4[j]; } }
        }
#pragma unroll
        for (int r = 0; r < 16; ++r) { if constexpr (!(PROBE & 4)) { p0[r] = __builtin_amdgcn_exp2f(p0[r]); p1[r] = __builtin_amdgcn_exp2f(p1[r]); } }
        bf16x8 pa[4];
#pragma unroll
        for (int s = 0; s < 2; ++s) {
            const v4u w0 = {cvtpk(p0[8 * s], p0[8 * s + 1]), cvtpk(p0[8 * s + 2], p0[8 * s + 3]), cvtpk(p0[8 * s + 4], p0[8 * s + 5]), cvtpk(p0[8 * s + 6], p0[8 * s + 7])};
            const v4u w1 = {cvtpk(p1[8 * s], p1[8 * s + 1]), cvtpk(p1[8 * s + 2], p1[8 * s + 3]), cvtpk(p1[8 * s + 4], p1[8 * s + 5]), cvtpk(p1[8 * s + 6], p1[8 * s + 7])};
            pa[s] = __builtin_bit_cast(bf16x8, w0); pa[2 + s] = __builtin_bit_cast(bf16x8, w1);
        }
        if constexpr (!(PROBE & 8))
#pragma unroll
        for (int s = 0; s < 4; ++s) {
            const s16x4 l0 = vtr(vbuf + s * 1024 + vfo), h0 = vtr(vbuf + s * 1024 + vfo + 512);
            const s16x4 l1 = vtr(vbuf + 4096 + s * 1024 + vfo), h1 = vtr(vbuf + 4096 + s * 1024 + vfo + 512);
            const bf16x8 b0 = {l0[0], l0[1], l0[2], l0[3], h0[0], h0[1], h0[2], h0[3]}, b1 = {l1[0], l1[1], l1[2], l1[3], h1[0], h1[1], h1[2], h1[3]};
            o0 = __builtin_amdgcn_mfma_f32_32x32x16_bf16(pa[s], b0, o0, 0, 0, 0);
            o1 = __builtin_amdgcn_mfma_f32_32x32x16_bf16(pa[s], b1, o1, 0, 0, 0);
            o2 = __builtin_amdgcn_mfma_f32_32x32x16_bf16(pa[s], ones, o2, 0, 0, 0);
        }
    }
#undef ATT_DMA
    LAS bf16* stg = (LAS bf16*)(lds + OST_OFF + wave * 4096);
#pragma unroll
    for (int r = 0; r < 16; ++r) { const int orow = crow(r, hi); const float rl = __builtin_amdgcn_rcpf(o2[r]);
        stg[orow * 64 + r32] = (bf16)f2bf(o0[r] * rl); stg[orow * 64 + 32 + r32] = (bf16)f2bf(o1[r] * rl); }
    asm volatile("s_waitcnt lgkmcnt(0)" ::: "memory");
#pragma unroll
    for (int i = 0; i < 4; ++i) {
        const int row = i * 8 + (lane >> 3), ch = lane & 7;
        const v4u v = *(const LAS v4u*)(stg + row * 64 + ch * 8);
        *(GAS v4u*)(MIX + (size_t)(row0 + row) * 1024 + h * 64 + ch * 8) = v;
        float f[8]; unpack8(v, f);
        float ss = (f[0] * f[0] + f[1] * f[1]) + (f[2] * f[2] + f[3] * f[3]) + (f[4] * f[4] + f[5] * f[5]) + (f[6] * f[6] + f[7] * f[7]);
        ss += __shfl_xor(ss, 1); ss += __shfl_xor(ss, 2); ss += __shfl_xor(ss, 4);
        if (ch == 0) ssqatt[(size_t)(row0 + row) * 8 + h] = ss;
    }
    asm volatile("s_waitcnt lgkmcnt(0)" ::: "memory"); __builtin_amdgcn_s_barrier(); asm volatile("" ::: "memory");
}
}
template <int PROBE> __device__ __forceinline__ void p3_attn(Frame& F, const Args& A) {
    const bf16 *Q = WSB(WS_Q), *KN = WSB(WS_KN), *VV = WSB(WS_VV), *KR = WSB(WS_KR); bf16* MIX = WSB(WS_MIX); float* ssqatt = F.sm + SM_SSQATT;
    const int slot = F.vcu % 3; bool tables_done = false;
    for (int item = F.vcu; item < 256; item += F.G) {
        const int bh = item >> 3, s = item & 7;
        if (!tables_done && slot != 1) { p0_tables(F, A, slot == 0 ? 0 : 1); __syncthreads(); }
        att::attn_unit<PROBE>(F.lds, bh >> 3, bh & 7, 15 - s, Q, KN, VV, KR, MIX, ssqatt, F.wave, F.lane);
        if (!tables_done && slot != 2) { p0_tables(F, A, slot == 1 ? 0 : 1); __syncthreads(); }
        att::attn_unit<PROBE>(F.lds, bh >> 3, bh & 7, s, Q, KN, VV, KR, MIX, ssqatt, F.wave, F.lane);
        if (!tables_done && slot != 0) { p0_tables(F, A, slot == 2 ? 0 : 1); __syncthreads(); }
        tables_done = true;
    }
    if (!tables_done) { p0_tables(F, A, 0); p0_tables(F, A, 1); }
}
template <int PROBE> __global__ void __launch_bounds__(NWAVES * 64, 2) mega(Args A) {
    extern __shared__ __attribute__((aligned(16))) unsigned char lds[];
    Frame F;
    F.lds = (LAS unsigned char*)lds;
    F.MISC = (volatile LAS unsigned*)(F.lds + MISC_OFF);
    F.tid = threadIdx.x; F.lane = F.tid & 63; F.wave = __builtin_amdgcn_readfirstlane(F.tid >> 6);
    F.G = gridDim.x; { const int bx = blockIdx.x; F.vcu = (F.G % 8 == 0) ? (bx % 8) * (F.G / 8) + bx / 8 : bx; }
    F.ws = A.ws; F.sm = (float*)(A.ws + WS_SMALL);
    for (int u = F.tid; u < (LDS_BYTES - LDSCTL_OFF) / 4; u += NWAVES * 64) ((LAS unsigned*)(F.lds + LDSCTL_OFF))[u] = 0u;
    __syncthreads();
    XcdBarrier bar = xcd_barrier_post((unsigned*)(A.ws + WS_CTL) + CW_BAR, F.MISC + 8, F.wave);
    const int lo = A.ph_lo, hi = A.ph_hi;
#define IN(k) (lo <= (k) && (k) < hi)
#ifndef PROBE_REPEAT_PHASE
#define PROBE_REPEAT_PHASE (-1)
#endif
#define REP(k) for (int rep_ = 0; rep_ < ((k) == PROBE_REPEAT_PHASE ? 2 : 1); ++rep_)
#define REP_BAR(k) do { if ((k) == PROBE_REPEAT_PHASE && rep_ == 0) GRID_BAR(); } while (0)
#define BOTH(k) (IN(k) && IN((k) + 1))
#define GRID_BAR() xcd_barrier(bar)
#define SMP(off) ((float*)(A.ws + WS_SMALL) + (off))
#define FRESH_IDS() do { const int l_ = lane_id64(); F.lane = l_; F.tid = F.wave * 64 + l_; } while (0)
    if (IN(0)) { FRESH_IDS(); REP(0) { p0_prologue(F, A); REP_BAR(0); } if (BOTH(0)) GRID_BAR(); }
    if (IN(1)) { FRESH_IDS(); REP(1) {
        p1_meta(F, A);
        pg8::Gemm g{WSB(WS_XB), WSB(WS_WIN), M, PN, 1024, 1024, 1024}; pg8::StaticOrder S; S.init(M, PN, F.G, (int)blockIdx.x);
        EpiInProj E{0, WSB(WS_P), SMP(SM_RSTD1), SMP(SM_SSQQ), SMP(SM_SSQKV), WSB(WS_KR), SMP(SM_ROPE)};
        pg8::gemm_phase<EpiInProj, pg8::StaticOrder, true, true>(F.lds + RING_OFF, g, S, E, F.wave);
        REP_BAR(1); }
        if (BOTH(1)) GRID_BAR();
    }
    if (IN(2)) { FRESH_IDS(); REP(2) {
        { pg8::Gemm g{WSB(WS_P) + O1, WSB(WS_WUKV), M, 1024, 128, PN, 128}; pg8::StaticOrder S; S.init(M, 1024, F.G, (int)blockIdx.x);
          EpiKV E{0, WSB(WS_KN), WSB(WS_VV), SMP(SM_SSQKV)};
          pg8::gemm_phase<EpiKV, pg8::StaticOrder, true, true>(F.lds + RING_OFF, g, S, E, F.wave); }
        { pg8::Gemm g{WSB(WS_P), WSB(WS_WUQ), M, 768, 256, PN, 256}; pg8::StaticOrder S; S.init(M, 768, F.G, (int)blockIdx.x);
          EpiQ E{0, WSB(WS_Q), SMP(SM_SSQQ), SMP(SM_ROPE)};
          pg8::gemm_phase<EpiQ, pg8::StaticOrder, true, true>(F.lds + RING_OFF, g, S, E, F.wave); }
        if (blockIdx.x >= 192 && F.G == 256) { FRESH_IDS(); p2_meta_kv(F, A, (int)blockIdx.x - 192); }
        else if (F.G != 256 && blockIdx.x < 64) { FRESH_IDS(); p2_meta_kv(F, A, (int)blockIdx.x); }
        FRESH_IDS();
        p2_conv(F, A);
        REP_BAR(2); }
        if (BOTH(2)) GRID_BAR();
    }
    if (IN(3)) { FRESH_IDS(); REP(3) { p3_attn<PROBE>(F, A); REP_BAR(3); } if (BOTH(3)) GRID_BAR(); }
    if (IN(4)) { FRESH_IDS(); REP(4) {
        pg8::StaticOrder S; S.init(M, 1024, F.G, (int)blockIdx.x); pg8::Unit u0;
        LAS float* tab = (LAS float*)(F.lds + TAB_OFF);
        if (S.next(0, u0) && F.tid < 256) {
            const int row = u0.pm * 256 + F.tid; const float* q = SMP(SM_SSQATT) + row * 8; float s = 0.f;
#pragma unroll
            for (int j = 0; j < 8; ++j) s += q[j];
            tab[F.tid] = rsqrtf(s * (1.f / 512.f) + EPS);
        }
        __syncthreads();
        pg8::Gemm g{WSB(WS_MIX), WSB(WS_WOUT), M, 1024, 1024, 1024, 1024};
        EpiOut E{8, WSB(WS_XB)  , SMP(SM_SSQ2), tab};
        pg8::gemm_phase<EpiOut, pg8::StaticOrder, true, true>(F.lds + RING_OFF, g, S, E, F.wave);
        REP_BAR(4); }
        if (BOTH(4)) GRID_BAR();
    }
    if (IN(5)) { FRESH_IDS(); REP(5) {
        pg8::Gemm g{WSB(WS_XB), WSB(WS_WQ), M, 2048, 1024, 1024, 1024}; pg8::StaticOrder S; S.init(M, 2048, F.G, (int)blockIdx.x);
        EpiQp E{0, WSB(WS_P)};
        pg8::gemm_phase<EpiQp, pg8::StaticOrder, true, true>(F.lds + RING_OFF, g, S, E, F.wave);
        VM_WAIT(); __syncthreads();
        if (F.tid == 0) { __builtin_amdgcn_fence(__ATOMIC_ACQUIRE, "agent"); VM_WAIT(); }
        __syncthreads();
        if constexpr (!(PROBE & 64)) p5_topk<PROBE>(F, A, S);
        REP_BAR(5); }
        if (BOTH(5)) GRID_BAR();
    }
    if (IN(6)) { FRESH_IDS(); REP(6) {
        p6_gather<PROBE>(F, A); REP_BAR(6); }
    }
#undef IN
#undef BOTH
}
}
extern "C" void kernel_launch(void* const* d_in, const int* in_sizes, int n_in, void* d_out, int out_size, void* d_ws, size_t ws_size, hipStream_t stream) {
    static int grid = 0;
    if (grid == 0) {
        if (n_in != 20 || in_sizes[0] != M * D_MODEL || out_size != M * D_MODEL || ws_size < WS_END) { fprintf(stderr, "kernel_launch: unexpected shapes / workspace (%d, %d, %d, %zu)\n", n_in, n_in > 0 ? in_sizes[0] : -1, out_size, ws_size); grid = -1; return; }
        int dev = 0, cus = 0, per_cu = 0;
        if (hipGetDevice(&dev) != hipSuccess || hipDeviceGetAttribute(&cus, hipDeviceAttributeMultiprocessorCount, dev) != hipSuccess) { grid = -1; return; }
        if (hipFuncSetAttribute((const void*)mega<0>, hipFuncAttributeMaxDynamicSharedMemorySize, LDS_BYTES) != hipSuccess) { fprintf(stderr, "kernel_launch: hipFuncSetAttribute failed\n"); grid = -1; return; }
        if (hipOccupancyMaxActiveBlocksPerMultiprocessor(&per_cu, (const void*)mega<0>, NWAVES * 64, LDS_BYTES) != hipSuccess || per_cu < 1) fprintf(stderr, "kernel_launch: occupancy query says %d\n", per_cu);
        (void)hipGetLastError();
        grid = cus;
        if (grid != 256) fprintf(stderr, "kernel_launch: %d CUs (expected 256)\n", grid);
    }
    if (grid < 0) return;
    (void)hipMemsetAsync((char*)d_ws + WS_CTL, 0, CTL_ZERO_BYTES, stream);
    Args a{};
    for (int i = 0; i < 20; ++i) a.in[i] = (const float*)d_in[i];
    a.out = (float*)d_out; a.ws = (unsigned char*)d_ws;
    auto launch = [&](int lo, int hi) { a.ph_lo = lo; a.ph_hi = hi; hipLaunchKernelGGL(mega<0>, dim3(grid), dim3(NWAVES * 64), LDS_BYTES, stream, a); };
    launch(0, 7);
#ifdef PROBE_EXTRA_PHASE
#ifdef PROBE_MODE
    (void)hipFuncSetAttribute((const void*)mega<PROBE_MODE>, hipFuncAttributeMaxDynamicSharedMemorySize, LDS_BYTES);
    a.ph_lo = PROBE_EXTRA_PHASE; a.ph_hi = PROBE_EXTRA_PHASE + 1; hipLaunchKernelGGL(mega<PROBE_MODE>, dim3(grid), dim3(NWAVES * 64), LDS_BYTES, stream, a);
#else
    launch(PROBE_EXTRA_PHASE, PROBE_EXTRA_PHASE + 1);
#endif
#endif
}
```

```cpp
#include <hip/hip_runtime.h>
#include <cstdio>
#include <cstdint>
namespace pg8 {
#define PG8_LAS __attribute__((address_space(3)))
typedef unsigned short bf16_t;
typedef short bf16x8 __attribute__((ext_vector_type(8)));
typedef float f32x4 __attribute__((ext_vector_type(4)));
typedef unsigned u32x4 __attribute__((ext_vector_type(4)));
typedef unsigned u32x2 __attribute__((ext_vector_type(2)));
constexpr int BM = 256, BK = 64, HALF = 128, HTB = HALF * BK * 2  , STAGE_BYTES = 8 * HTB, NXCD = 8, WGM = 8;

__host__ __device__ __forceinline__ int lds_byte(int r, int c) { const int st = (r >> 4) * 2 + (c >> 5), rr = r & 15, cc = c & 31, ob = rr * 64 + cc * 2; return st * 1024 + (ob ^ (((ob >> 9) & 1) << 5)); }
__host__ __device__ __forceinline__ void stage_rc(int b, int& R, int& C) { const int st = b / 1024, sb = b % 1024, swz = sb ^ (((sb >> 9) & 1) << 5); R = (st >> 1) * 16 + swz / 64; C = (st & 1) * 32 + (swz % 64) / 2; }
__host__ __device__ __forceinline__ int perm32(int rho) { const int n = rho >> 4, i = rho & 15; return 8 * (i >> 2) + 4 * n + (i & 3); }

struct Unit { int pm, pn; };
struct Gemm { const bf16_t* A; const bf16_t* Bt; int M, N, K, lda, ldb; };

struct StaticOrder {
    int nM, nN, nwg, G, c;
    __host__ __device__ __forceinline__ void init(int M, int N, int G_, int c_) { nM = M / BM; nN = N / BM; nwg = nM * nN; G = G_; c = c_; }
    __host__ __device__ __forceinline__ bool next(int i, Unit& u) const {
        const long L = (long)i * G + c; if (L >= nwg) return false;
        int wgid = (int)L; { const int q = nwg / NXCD, r = nwg % NXCD, xcd = wgid % NXCD, off = wgid / NXCD; wgid = (xcd < r ? xcd * (q + 1) : r * (q + 1) + (xcd - r) * q) + off; }
        const int nig = WGM * nN, gid = wgid / nig, fm = gid * WGM, gsz = (nM - fm) < WGM ? (nM - fm) : WGM;
        u.pm = fm + ((wgid % nig) % gsz); u.pn = (wgid % nig) / gsz; return true;
    }
};

__device__ __forceinline__ unsigned cvt_pk_bf16(float lo, float hi) { unsigned r; asm volatile("v_cvt_pk_bf16_f32 %0, %1, %2" : "=v"(r) : "v"(lo), "v"(hi)); return r; }

template <class Epi, class Sched, bool ALIGN_EPI = false, bool SP2 = false>
__device__ __forceinline__ void gemm_phase(PG8_LAS unsigned char* lds, const Gemm g, const Sched& S, const Epi& E, const int wave_id) {
    int lane_ = (int)__builtin_amdgcn_mbcnt_hi(~0u, __builtin_amdgcn_mbcnt_lo(~0u, 0u)); asm volatile("" : "+v"(lane_));
    const int wid = wave_id, lane = lane_, tid = wid * 64 + lane, wr = wid >> 2, wc = wid & 3, fr = lane & 15, fq = lane >> 4;
    const int K = g.K, nt = K / BK;
    unsigned voffA[2], voffB[2];
#pragma unroll
    for (int i = 0; i < 2; ++i) { int R, C; stage_rc(tid * 16 + i * 8192, R, C); const int Rb = Epi::PERM ? ((R & ~31) + perm32(R & 31)) : R;
        voffA[i] = (unsigned)(R * g.lda + C) * 2u; voffB[i] = (unsigned)(Rb * g.ldb + C) * 2u; }
    const size_t kstep = (size_t)(BK * 2);
    const size_t hstepA = (size_t)HALF * g.lda * 2, hstepB = (size_t)HALF * g.ldb * 2;
    const size_t tstepA = 2 * hstepA, tstepB = 2 * hstepB;
    const unsigned ldsw = (unsigned)wid * 1024u;
    const int aoff = lds_byte(wr * 64 + fr, fq * 8), boff = lds_byte(wc * 32 + fr, fq * 8);
#define PG8_SA(b, h) (((b) * 2 + (h)) * HTB)
#define PG8_SB(b, h) ((4 + (b) * 2 + (h)) * HTB)
#define PG8_STAGE(bufoff, gbase, voff) do { _Pragma("unroll") for (int _i = 0; _i < 2; ++_i) \
        __builtin_amdgcn_global_load_lds((const unsigned*)((const char*)(gbase) + (voff)[_i]), (PG8_LAS unsigned*)(lds + (bufoff) + ldsw + _i * 8192), 16, 0, 0); } while (0)
#define PG8_LDA(dst, b, h) do { _Pragma("unroll") for (int m = 0; m < 4; ++m) _Pragma("unroll") for (int k = 0; k < 2; ++k) dst[m][k] = *(const PG8_LAS bf16x8*)(lds + PG8_SA(b, h) + aoff + m * 2048 + k * 1024); } while (0)
#define PG8_LDB(dst, b, h) do { _Pragma("unroll") for (int n = 0; n < 2; ++n) _Pragma("unroll") for (int k = 0; k < 2; ++k) dst[n][k] = *(const PG8_LAS bf16x8*)(lds + PG8_SB(b, h) + boff + n * 2048 + k * 1024); } while (0)
#define PG8_MMA(ai, bj, At, Bt) do { __builtin_amdgcn_s_setprio(1); _Pragma("unroll") for (int m = 0; m < 4; ++m) _Pragma("unroll") for (int n = 0; n < 2; ++n) _Pragma("unroll") for (int k = 0; k < 2; ++k) \
        acc[ai][bj][m][n] = __builtin_amdgcn_mfma_f32_16x16x32_bf16(Bt[n][k], At[m][k], acc[ai][bj][m][n], 0, 0, 0); __builtin_amdgcn_s_setprio(0); } while (0)
#define PG8_WAIT_V(n) asm volatile("s_waitcnt vmcnt(" #n ")" ::: "memory")
#define PG8_WAIT_L(n) asm volatile("s_waitcnt lgkmcnt(" #n ")" ::: "memory")
#define PG8_BAR __builtin_amdgcn_s_barrier()
#define PG8_SCHED __builtin_amdgcn_sched_barrier(0)
    Unit cur, nxt; int ui = 0;
    if (!S.next(0, cur)) return;
    f32x4 acc[2][2][4][2];
#pragma unroll
    for (int a = 0; a < 2; ++a)
#pragma unroll
        for (int b = 0; b < 2; ++b)
#pragma unroll
            for (int m = 0; m < 4; ++m)
#pragma unroll
                for (int n = 0; n < 2; ++n) acc[a][b][m][n] = (f32x4){0.f, 0.f, 0.f, 0.f};
    bf16x8 At[4][2], B0[2][2], B1[2][2];
    const char* cA = (const char*)g.A + (size_t)cur.pm * tstepA; const char* cB = (const char*)g.Bt + (size_t)cur.pn * tstepB;
    if constexpr (SP2) {
        PG8_STAGE(PG8_SB(0, 0), cB, voffB); PG8_STAGE(PG8_SB(0, 1), cB + hstepB, voffB); PG8_STAGE(PG8_SA(0, 0), cA, voffA); PG8_STAGE(PG8_SA(0, 1), cA + hstepA, voffA);
        if (wr == 1) PG8_BAR;
        PG8_WAIT_V(2); PG8_BAR;
        PG8_STAGE(PG8_SB(1, 0), cB + kstep, voffB); PG8_STAGE(PG8_SA(1, 0), cA + kstep, voffA); PG8_STAGE(PG8_SB(1, 1), cB + hstepB + kstep, voffB);
        PG8_WAIT_V(6); PG8_BAR;
    } else {
        PG8_STAGE(PG8_SB(0, 0), cB, voffB); PG8_STAGE(PG8_SA(0, 0), cA, voffA); PG8_STAGE(PG8_SB(0, 1), cB + hstepB, voffB); PG8_STAGE(PG8_SA(0, 1), cA + hstepA, voffA);
        if (wr == 1) PG8_BAR;
        PG8_WAIT_V(4); PG8_BAR;
        PG8_STAGE(PG8_SB(1, 0), cB + kstep, voffB); PG8_STAGE(PG8_SA(1, 0), cA + kstep, voffA); PG8_STAGE(PG8_SB(1, 1), cB + hstepB + kstep, voffB);
        PG8_WAIT_V(6); PG8_BAR;
    }
    for (;;) {
        const bool has_next = S.next(ui + 1, nxt);
        const char* nA = has_next ? (const char*)g.A + (size_t)nxt.pm * tstepA : cA; const char* nB = has_next ? (const char*)g.Bt + (size_t)nxt.pn * tstepB : cB;
        for (int t = 0; t < nt; t += 2) {
            const bool last = (t == nt - 2);
            const char* a1 = cA + (size_t)(t + 1) * kstep;
            const char* a2 = last ? nA : cA + (size_t)(t + 2) * kstep; const char* b2 = last ? nB : cB + (size_t)(t + 2) * kstep;
            const char* a3 = a2 + kstep; const char* b3 = b2 + kstep;
            if constexpr (Epi::HAS_MID) { if (t == E.mid_t) E.mid(acc, cur, wr, wc, fr, fq); }
            if constexpr (SP2) {
            PG8_LDB(B0, 0, 0); PG8_LDB(B1, 0, 1); PG8_SCHED; PG8_LDA(At, 0, 0); PG8_STAGE(PG8_SA(1, 1), a1 + hstepA, voffA);
            PG8_WAIT_V(8); PG8_WAIT_L(0); PG8_BAR; PG8_MMA(0, 0, At, B0); PG8_MMA(0, 1, At, B1); PG8_BAR; PG8_SCHED;
            PG8_LDA(At, 0, 1); PG8_STAGE(PG8_SB(0, 0), b2, voffB); PG8_STAGE(PG8_SB(0, 1), b2 + hstepB, voffB); PG8_STAGE(PG8_SA(0, 0), a2, voffA);
            PG8_WAIT_V(8); PG8_WAIT_L(0); PG8_BAR; PG8_MMA(1, 0, At, B0); PG8_MMA(1, 1, At, B1); PG8_BAR; PG8_SCHED;
            PG8_LDB(B0, 1, 0); PG8_LDB(B1, 1, 1); PG8_SCHED; PG8_LDA(At, 1, 0); PG8_STAGE(PG8_SA(0, 1), a2 + hstepA, voffA);
            PG8_WAIT_V(8); PG8_WAIT_L(0); PG8_BAR; PG8_MMA(0, 0, At, B0); PG8_MMA(0, 1, At, B1); PG8_BAR; PG8_SCHED;
            PG8_LDA(At, 1, 1); PG8_STAGE(PG8_SB(1, 0), b3, voffB); PG8_STAGE(PG8_SB(1, 1), b3 + hstepB, voffB); PG8_STAGE(PG8_SA(1, 0), a3, voffA);
            PG8_WAIT_V(8); PG8_WAIT_L(0); PG8_BAR; PG8_MMA(1, 0, At, B0); PG8_MMA(1, 1, At, B1); PG8_BAR; PG8_SCHED;
            } else {
            PG8_LDB(B0, 0, 0); PG8_SCHED; PG8_LDA(At, 0, 0); PG8_STAGE(PG8_SA(1, 1), a1 + hstepA, voffA);
            PG8_WAIT_L(8); PG8_BAR; PG8_WAIT_L(0); PG8_MMA(0, 0, At, B0); PG8_BAR; PG8_SCHED;
            PG8_LDB(B1, 0, 1); PG8_STAGE(PG8_SB(0, 0), b2, voffB);
            PG8_BAR; PG8_WAIT_L(0); PG8_MMA(0, 1, At, B1); PG8_BAR;
            PG8_LDA(At, 0, 1); PG8_STAGE(PG8_SA(0, 0), a2, voffA);
            PG8_BAR; PG8_WAIT_L(0); PG8_MMA(1, 0, At, B0); PG8_BAR; PG8_SCHED;
            PG8_STAGE(PG8_SB(0, 1), b2 + hstepB, voffB);
            PG8_WAIT_V(6); PG8_BAR; PG8_MMA(1, 1, At, B1); PG8_BAR;
            PG8_LDB(B0, 1, 0); PG8_SCHED; PG8_LDA(At, 1, 0); PG8_STAGE(PG8_SA(0, 1), a2 + hstepA, voffA);
            PG8_WAIT_L(8); PG8_BAR; PG8_WAIT_L(0); PG8_MMA(0, 0, At, B0); PG8_BAR; PG8_SCHED;
            PG8_LDB(B1, 1, 1); PG8_STAGE(PG8_SB(1, 0), b3, voffB);
            PG8_BAR; PG8_WAIT_L(0); PG8_MMA(0, 1, At, B1); PG8_BAR;
            PG8_LDA(At, 1, 1); PG8_STAGE(PG8_SA(1, 0), a3, voffA);
            PG8_BAR; PG8_WAIT_L(0); PG8_MMA(1, 0, At, B0); PG8_BAR; PG8_SCHED;
            PG8_STAGE(PG8_SB(1, 1), b3 + hstepB, voffB);
            PG8_WAIT_V(6); PG8_BAR; PG8_MMA(1, 1, At, B1); PG8_BAR;
            }
        }
        if constexpr (ALIGN_EPI) { if (wr == 0) PG8_BAR; }
        E(acc, cur, wr, wc, fr, fq);
        if (!has_next) break;
#pragma unroll
        for (int a = 0; a < 2; ++a)
#pragma unroll
            for (int b = 0; b < 2; ++b)
#pragma unroll
                for (int m = 0; m < 4; ++m)
#pragma unroll
                    for (int n = 0; n < 2; ++n) acc[a][b][m][n] = (f32x4){0.f, 0.f, 0.f, 0.f};
        cur = nxt; cA = nA; cB = nB; ++ui;
        if constexpr (ALIGN_EPI) { if (wr == 1) PG8_BAR; }
    }
    PG8_WAIT_V(0);
    if constexpr (!ALIGN_EPI) { if (wr == 0) PG8_BAR; }
    PG8_BAR;
#undef PG8_SA
#undef PG8_SB
#undef PG8_STAGE
#undef PG8_LDA
#undef PG8_LDB
#undef PG8_MMA
#undef PG8_WAIT_V
#undef PG8_WAIT_L
#undef PG8_BAR
#undef PG8_SCHED
}
}
namespace {
constexpr int D_MODEL = 1024, BATCH = 4, SEQ = 4096, N_META = 16;
constexpr int M = BATCH * SEQ;
constexpr float EPS = 1e-6f;
constexpr int IN_COLS = 1952, PN = 2048;
constexpr int O1 = 256, O2 = 384, O3 = 416, O4 = 928, O5 = 1440;
constexpr int KVROWS = 64 + SEQ;
constexpr int NEXP = 16384;
constexpr float QSCALE = 0.10206207261596575f * 1.4426950408889634f;
constexpr int NWAVES = 8;

constexpr size_t MiB = 1u << 20;
constexpr size_t WS_CTL = 0, CTL_ZERO_BYTES = 64 * 1024;
constexpr size_t WS_SMALL = 1 * MiB;
constexpr size_t WS_WIN = 4 * MiB;
constexpr size_t WS_WQ = 8 * MiB;
constexpr size_t WS_WOUT = 12 * MiB;
constexpr size_t WS_WUQ = 14 * MiB;
constexpr size_t WS_WUKV = 14 * MiB + 512 * 1024;
constexpr size_t WS_KEYS = 14 * MiB + 768 * 1024;
constexpr size_t WS_U = 15 * MiB;
constexpr size_t WS_V = 31 * MiB;
constexpr size_t WS_Q = 44 * MiB;
constexpr size_t WS_P = 79 * MiB;
constexpr size_t WS_XB = 143 * MiB;
constexpr size_t WS_KN = 175 * MiB;
constexpr size_t WS_VV = 192 * MiB;
constexpr size_t WS_KR = 209 * MiB;
constexpr size_t WS_MIX = 211 * MiB;
constexpr size_t WS_IDX = WS_MIX, WS_GATE = WS_MIX + 8 * MiB;
constexpr size_t WS_PMP = 243 * MiB;
constexpr size_t WS_END = 245 * MiB;
constexpr int SM_RSTD1 = 0;
constexpr int SM_SSQQ = SM_RSTD1 + M;
constexpr int SM_SSQKV = SM_SSQQ + 4 * M;
constexpr int SM_SSQATT = SM_SSQKV + 4 * M;
constexpr int SM_SSQ2 = SM_SSQATT + 8 * M;
constexpr int SM_ZMETA = SM_SSQ2 + 16 * M;
constexpr int SM_ROPE = SM_ZMETA + 1024;
constexpr int SM_SU = SM_ROPE + (N_META + SEQ) * 32;
constexpr int SM_SV = SM_SU + NEXP;
constexpr int SM_END = SM_SV + NEXP;
static_assert((size_t)SM_END * 4 <= 3 * MiB, "small arrays");
static_assert(WS_KN + (size_t)BATCH * KVROWS * 512 * 2 <= WS_VV && WS_VV + (size_t)BATCH * KVROWS * 512 * 2 <= WS_KR && WS_KR + (size_t)BATCH * KVROWS * 64 <= WS_MIX, "kv map");
constexpr int CW_BAR = 1024;

constexpr int RING_OFF = 0, RING_BYTES = 131072;
constexpr int LDSCTL_OFF = RING_BYTES, MISC_OFF = LDSCTL_OFF + 320;
constexpr int TAB_OFF = RING_BYTES + 1024;
constexpr int LDS_BYTES = 147456;

#define GAS __attribute__((address_space(1)))
#define LAS __attribute__((address_space(3)))
typedef unsigned short bf16;
typedef unsigned v4u __attribute__((ext_vector_type(4)));
typedef unsigned v2u __attribute__((ext_vector_type(2)));
typedef float f32x4 __attribute__((ext_vector_type(4)));
typedef GAS unsigned gu32;
#define RLX_AGENT __ATOMIC_RELAXED, __HIP_MEMORY_SCOPE_AGENT
#define LDS_WAIT() asm volatile("s_waitcnt lgkmcnt(0)" ::: "memory")
#define VM_WAIT() asm volatile("s_waitcnt vmcnt(0)" ::: "memory")
__device__ __forceinline__ unsigned f2bf(float f) { unsigned u = __builtin_bit_cast(unsigned, f); return (u + 0x7fffu + ((u >> 16) & 1u)) >> 16; }
__device__ __forceinline__ unsigned pk2(float lo, float hi) { return f2bf(lo) | (f2bf(hi) << 16); }
__device__ __forceinline__ float bf_lo(unsigned w) { return __builtin_bit_cast(float, w << 16); }
__device__ __forceinline__ float bf_hi(unsigned w) { return __builtin_bit_cast(float, w & 0xffff0000u); }
__device__ __forceinline__ float bf2f(bf16 h) { return __builtin_bit_cast(float, (unsigned)h << 16); }
template <int CTRL> __device__ __forceinline__ float fdpp(float v) { return __builtin_bit_cast(float, __builtin_amdgcn_update_dpp(0, __builtin_bit_cast(int, v), CTRL, 0xF, 0xF, false)); }
__device__ __forceinline__ int lane_id64() { int l; asm volatile("v_mbcnt_lo_u32_b32 %0, -1, 0\n\tv_mbcnt_hi_u32_b32 %0, -1, %0" : "=v"(l)); return l; }
__device__ __forceinline__ int ix32(int v) { return __builtin_amdgcn_ds_bpermute((lane_id64() ^ 32) << 2, v); }
__device__ __forceinline__ float wave_sum(float v) {
    v += fdpp<0x128>(v); v += fdpp<0x141>(v); v += fdpp<0x4E>(v); v += fdpp<0xB1>(v);
    float a = v, b = v; asm volatile("s_nop 1\n\tv_permlane16_swap_b32 %0, %1" : "+v"(a), "+v"(b)); a += b; b = a;
    asm volatile("s_nop 1\n\tv_permlane32_swap_b32 %0, %1" : "+v"(a), "+v"(b)); return a + b;
}
__device__ __forceinline__ float wave_max(float v) {
    v = fmaxf(v, fdpp<0x128>(v)); v = fmaxf(v, fdpp<0x141>(v)); v = fmaxf(v, fdpp<0x4E>(v)); v = fmaxf(v, fdpp<0xB1>(v));
    float a = v, b = v; asm volatile("s_nop 1\n\tv_permlane16_swap_b32 %0, %1" : "+v"(a), "+v"(b)); a = fmaxf(a, b); b = a;
    asm volatile("s_nop 1\n\tv_permlane32_swap_b32 %0, %1" : "+v"(a), "+v"(b)); return fmaxf(a, b);
}

__device__ __forceinline__ float half_max(float v) {
    v = fmaxf(v, fdpp<0x128>(v)); v = fmaxf(v, fdpp<0x141>(v)); v = fmaxf(v, fdpp<0x4E>(v)); v = fmaxf(v, fdpp<0xB1>(v));
    float a = v, b = v; asm volatile("s_nop 1\n\tv_permlane16_swap_b32 %0, %1" : "+v"(a), "+v"(b)); return fmaxf(a, b);
}
typedef _Float16 v32h __attribute__((ext_vector_type(32)));
typedef unsigned v6u __attribute__((ext_vector_type(6)));

#define XB_TMO      128
#define XB_XCNT(j)  (256  + 64 * (j))
#define XB_XSUB(j)  (1280 + 64 * (j))
#define XB_XGEN(j)  (2304 + 64 * (j))
#define XB_TOP      3328
#define XB_TOPGEN   3392
#define XCD_BAR_WORDS 3456
#define XB_SPIN_CAP (1u << 18)
__device__ __forceinline__ unsigned xb_ld(unsigned* p)              { return __hip_atomic_load(p, __ATOMIC_RELAXED, __HIP_MEMORY_SCOPE_AGENT); }
__device__ __forceinline__ unsigned xb_add(unsigned* p, unsigned v) { return __hip_atomic_fetch_add(p, v, __ATOMIC_RELAXED, __HIP_MEMORY_SCOPE_AGENT); }
__device__ __forceinline__ unsigned xb_xcc_id() { return (unsigned)__builtin_amdgcn_s_getreg((3 << 11) | 20) & 0xFu; }
#define XB_SPIN(cond, bar) do { unsigned _sp = 0; while (cond) { __builtin_amdgcn_s_sleep(1); \
    if ((++_sp & 255u) == 0u) { if (xb_ld(&(bar)[XB_TMO])) break; if (_sp > XB_SPIN_CAP) { atomicAdd(&(bar)[XB_TMO], 1u); break; } } } } while (0)
struct XcdBarrier { unsigned* bar; unsigned x; volatile LAS unsigned* st; int wave; };
__device__ __forceinline__ XcdBarrier xcd_barrier_post(unsigned* bar, volatile LAS unsigned* st, int wave) {
    XcdBarrier b; b.bar = bar; b.x = xb_xcc_id(); b.st = st; b.wave = wave;
    if (wave == 0 && lane_id64() == 0) (void)xb_add(&bar[XB_XCNT(b.x)], 1u);
    return b;
}
__device__ __forceinline__ void xcd_barrier_complete(unsigned* bar, unsigned x, unsigned& nloc, unsigned& nx) {
    const unsigned G = gridDim.x * gridDim.y * gridDim.z;
    unsigned sum, cnt, mine, sp = 0u;
    for (;;) {
        sum = 0u; cnt = 0u; mine = 0u;
#pragma unroll
        for (unsigned j = 0; j < 16; ++j) { const unsigned c = xb_ld(&bar[XB_XCNT(j)]); sum += c; cnt += (c > 0u) ? 1u : 0u; mine = (j == x) ? c : mine; }
        if (sum == G) break;
        __builtin_amdgcn_s_sleep(1);
        if ((++sp & 255u) == 0u) { if (xb_ld(&bar[XB_TMO])) break; if (sp > XB_SPIN_CAP) { atomicAdd(&bar[XB_TMO], 1u); break; } }
    }
    nloc = mine > 0u ? mine : 1u; nx = cnt > 0u ? cnt : 1u;
}
__device__ __forceinline__ void xcd_barrier(const XcdBarrier& b) {
    asm volatile("s_waitcnt vmcnt(0)" ::: "memory");
    __syncthreads();
    if (b.wave == 0 && lane_id64() == 0) {
        unsigned* bar = b.bar;
        __builtin_amdgcn_s_waitcnt(0);
        unsigned nloc = b.st[0], nx = b.st[1];
        if (nloc == 0u) { xcd_barrier_complete(bar, b.x, nloc, nx); b.st[0] = nloc; b.st[1] = nx; }
        const unsigned old = xb_add(&bar[XB_XSUB(b.x)], 1u);
        const unsigned gen = old / nloc;
        if (old + 1u == (gen + 1u) * nloc) {
            __builtin_amdgcn_fence(__ATOMIC_RELEASE, "agent");
            asm volatile("s_waitcnt vmcnt(0)" ::: "memory");
            const unsigned og = xb_add(&bar[XB_TOP], 1u);
            const unsigned tg = og / nx;
            if (og + 1u == (tg + 1u) * nx) xb_add(&bar[XB_TOPGEN], 1u);
            else XB_SPIN(xb_ld(&bar[XB_TOPGEN]) == tg, bar);
            __builtin_amdgcn_fence(__ATOMIC_ACQUIRE, "agent");
            xb_add(&bar[XB_XGEN(b.x)], 1u);
            asm volatile("s_waitcnt vmcnt(0)" ::: "memory");
        } else {
            XB_SPIN(xb_ld(&bar[XB_XGEN(b.x)]) == gen, bar);
            __builtin_amdgcn_fence(__ATOMIC_ACQUIRE, "agent");
            asm volatile("s_waitcnt vmcnt(0)" ::: "memory");
        }
    }
    __syncthreads();
}

template <class Fn> __device__ __forceinline__ void xcd_barrier_fill(const XcdBarrier& b, Fn&& filler) {
    asm volatile("s_waitcnt vmcnt(0)" ::: "memory");
    __syncthreads();
    unsigned role = 0u, gen = 0u, tg = 0u;
    if (b.wave == 0 && lane_id64() == 0) {
        unsigned* bar = b.bar;
        __builtin_amdgcn_s_waitcnt(0);
        unsigned nloc = b.st[0], nx = b.st[1];
        if (nloc == 0u) { xcd_barrier_complete(bar, b.x, nloc, nx); b.st[0] = nloc; b.st[1] = nx; }
        const unsigned old = xb_add(&bar[XB_XSUB(b.x)], 1u);
        gen = old / nloc;
        if (old + 1u == (gen + 1u) * nloc) {
            __builtin_amdgcn_fence(__ATOMIC_RELEASE, "agent");
            asm volatile("s_waitcnt vmcnt(0)" ::: "memory");
            const unsigned nx2 = b.st[1];
            const unsigned og = xb_add(&bar[XB_TOP], 1u);
            tg = og / nx2;
            if (og + 1u == (tg + 1u) * nx2) { xb_add(&bar[XB_TOPGEN], 1u); role = 2u; } else role = 1u;
        }
    }
    filler();
    if (b.wave == 0 && lane_id64() == 0) {
        unsigned* bar = b.bar;
        if (role != 0u) {
            if (role == 1u) XB_SPIN(xb_ld(&bar[XB_TOPGEN]) == tg, bar);
            __builtin_amdgcn_fence(__ATOMIC_ACQUIRE, "agent");
            xb_add(&bar[XB_XGEN(b.x)], 1u);
            asm volatile("s_waitcnt vmcnt(0)" ::: "memory");
        } else {
            XB_SPIN(xb_ld(&bar[XB_XGEN(b.x)]) == gen, bar);
            __builtin_amdgcn_fence(__ATOMIC_ACQUIRE, "agent");
            asm volatile("s_waitcnt vmcnt(0)" ::: "memory");
        }
    }
    __syncthreads();
}

struct Args { const float* in[20]; float* out; unsigned char* ws; int ph_lo, ph_hi; };
struct Frame {
    LAS unsigned char* lds;
    volatile LAS unsigned* MISC;
    int tid, lane, wave, vcu, G;
    unsigned char* ws; float* sm;
};
#define IN_x         (A.in[0])
#define IN_meta      (A.in[1])
#define IN_norm1_g   (A.in[2])
#define IN_w_in      (A.in[3])
#define IN_q_norm_g  (A.in[4])
#define IN_w_uq      (A.in[5])
#define IN_kv_norm_g (A.in[6])
#define IN_w_ukv     (A.in[7])
#define IN_conv_w    (A.in[8])
#define IN_conv_b    (A.in[9])
#define IN_attn_out_g (A.in[10])
#define IN_conv_out_g (A.in[11])
#define IN_w_out     (A.in[12])
#define IN_norm2_g   (A.in[13])
#define IN_w_query   (A.in[14])
#define IN_keys1     (A.in[15])
#define IN_keys2     (A.in[16])
#define IN_peer_u    (A.in[17])
#define IN_peer_v    (A.in[18])
#define IN_final_g   (A.in[19])
#define WSB(off)     ((bf16*)(F.ws + (off)))
__device__ __forceinline__ void p0_transpose_item(const float* W, int K, int N, const float* g, bf16* WT, LAS float* scr, int item, int lane) {
    const int nblk = N / 32, kb = item / nblk, nb = item % nblk, k0 = 64 * kb, n0 = 32 * nb;
#pragma unroll 8
    for (int i = 0; i < 32; ++i) { const int kk = 2 * i + (lane >> 5); scr[kk * 33 + (lane & 31)] = __builtin_nontemporal_load(W + (size_t)(k0 + kk) * N + n0 + (lane & 31)) * g[k0 + kk]; }
    LDS_WAIT(); asm volatile("" ::: "memory");
    const int c = lane & 7;
#pragma unroll
    for (int j = 0; j < 4; ++j) { const int n = (lane >> 3) + 8 * j; const LAS float* s = scr + (8 * c) * 33 + n;
        v4u o; o.x = pk2(s[0 * 33], s[1 * 33]); o.y = pk2(s[2 * 33], s[3 * 33]); o.z = pk2(s[4 * 33], s[5 * 33]); o.w = pk2(s[6 * 33], s[7 * 33]);
        *(GAS v4u*)(WT + (size_t)(n0 + n) * K + k0 + 8 * c) = o; }
    LDS_WAIT(); asm volatile("" ::: "memory");
}
__device__ __forceinline__ float row_to_bf16(const float* src, const float* gain, bf16* dst, int lane) {
    const GAS f32x4* s4 = (const GAS f32x4*)src;
    f32x4 a0 = s4[2 * lane], a1 = s4[2 * lane + 1], b0 = s4[128 + 2 * lane], b1 = s4[128 + 2 * lane + 1];
    float ss = (a0.x * a0.x + a0.y * a0.y) + (a0.z * a0.z + a0.w * a0.w) + (a1.x * a1.x + a1.y * a1.y) + (a1.z * a1.z + a1.w * a1.w)
             + (b0.x * b0.x + b0.y * b0.y) + (b0.z * b0.z + b0.w * b0.w) + (b1.x * b1.x + b1.y * b1.y) + (b1.z * b1.z + b1.w * b1.w);
    if (gain) { const GAS f32x4* g4 = (const GAS f32x4*)gain; a0 = a0 * g4[2 * lane]; a1 = a1 * g4[2 * lane + 1]; b0 = b0 * g4[128 + 2 * lane]; b1 = b1 * g4[128 + 2 * lane + 1]; }
    v4u o0, o1; o0.x = pk2(a0.x, a0.y); o0.y = pk2(a0.z, a0.w); o0.z = pk2(a1.x, a1.y); o0.w = pk2(a1.z, a1.w);
    o1.x = pk2(b0.x, b0.y); o1.y = pk2(b0.z, b0.w); o1.z = pk2(b1.x, b1.y); o1.w = pk2(b1.z, b1.w);
    GAS v4u* d4 = (GAS v4u*)dst; d4[lane] = o0; d4[64 + lane] = o1;
    return ss;
}
__device__ __forceinline__ void p0_tables(Frame& F, const Args& A, const int piece) {
    const int lane = lane_id64(), gw = F.vcu * NWAVES + F.wave, NGW = F.G * NWAVES;
    if (piece < 4) for (int it0 = gw + piece * 2 * NGW; it0 < NEXP; it0 += 8 * NGW) {
        f32x4 a[2][4]; int ee[2]; bool val[2];
#pragma unroll
        for (int q = 0; q < 2; ++q) {
            const int it = it0 + q * NGW; val[q] = it < NEXP; ee[q] = val[q] ? it : 0;
            const GAS f32x4* s4 = (const GAS f32x4*)(IN_peer_u + (size_t)ee[q] * 1024) + 4 * lane;
#pragma unroll
            for (int j = 0; j < 4; ++j) a[q][j] = __builtin_nontemporal_load(s4 + j);
        }
        const GAS f32x4* g4 = (const GAS f32x4*)IN_norm2_g + 4 * lane;
#pragma unroll
        for (int q = 0; q < 2; ++q) {
            float am = 0.f;
#pragma unroll
            for (int j = 0; j < 4; ++j) { a[q][j] = a[q][j] * g4[j]; am = fmaxf(fmaxf(am, fmaxf(fabsf(a[q][j].x), fabsf(a[q][j].y))), fmaxf(fabsf(a[q][j].z), fabsf(a[q][j].w))); }
            am = wave_max(am);
            v4u o;
            const float inv = am > 0.f ? 127.f / am : 0.f;
#pragma unroll
            for (int j = 0; j < 4; ++j) {
                const unsigned b0 = (unsigned)(int)rintf(a[q][j].x * inv) & 255u, b1 = (unsigned)(int)rintf(a[q][j].y * inv) & 255u;
                const unsigned b2 = (unsigned)(int)rintf(a[q][j].z * inv) & 255u, b3 = (unsigned)(int)rintf(a[q][j].w * inv) & 255u;
                o[j] = b0 | (b1 << 8) | (b2 << 16) | (b3 << 24);
            }
            if (val[q]) {
                __builtin_nontemporal_store(o, (GAS v4u*)(F.ws + WS_U + (size_t)ee[q] * 1024 + 16 * lane));
                if (lane == 0) F.sm[SM_SU + ee[q]] = am * (1.f / 127.f);
            }
        }
    }
    if (piece >= 4) for (int p0 = gw + (piece - 4) * 2 * NGW; p0 < NEXP / 2; p0 += 4 * NGW) {
        f32x4 a[2][8]; bool val[2]; int ee[2];
        const int half = lane >> 5, l31 = lane & 31;
#pragma unroll
        for (int q = 0; q < 2; ++q) {
            const int pr = p0 + q * NGW; val[q] = pr < NEXP / 2; ee[q] = 2 * (val[q] ? pr : 0) + half;
            const GAS f32x4* s4 = (const GAS f32x4*)(IN_peer_v + (size_t)ee[q] * 1024) + l31;
#pragma unroll
            for (int j = 0; j < 8; ++j) a[q][j] = __builtin_nontemporal_load(s4 + 32 * j);
        }
#pragma unroll
        for (int q = 0; q < 2; ++q) {
            float am = 0.f;
#pragma unroll
            for (int j = 0; j < 8; ++j) am = fmaxf(fmaxf(am, fmaxf(fabsf(a[q][j].x), fabsf(a[q][j].y))), fmaxf(fabsf(a[q][j].z), fabsf(a[q][j].w)));
            am = half_max(am);
            const float inv = am > 0.f ? 7.5f / am : 0.f;
            v32h hv;
#pragma unroll
            for (int j = 0; j < 8; ++j) { hv[4 * j] = (_Float16)(a[q][j].x * inv); hv[4 * j + 1] = (_Float16)(a[q][j].y * inv); hv[4 * j + 2] = (_Float16)(a[q][j].z * inv); hv[4 * j + 3] = (_Float16)(a[q][j].w * inv); }
            const v6u pk = __builtin_amdgcn_cvt_scalef32_pk32_fp6_f16(hv, 1.0f);
            if (val[q]) {
                unsigned char* rowp = F.ws + WS_V + (size_t)ee[q] * 768;
                __builtin_nontemporal_store((v4u){pk[0], pk[1], pk[2], pk[3]}, (GAS v4u*)(rowp + 16 * l31)); __builtin_nontemporal_store((v2u){pk[4], pk[5]}, (GAS v2u*)(rowp + 512 + 8 * l31));
                if (l31 == 0) F.sm[SM_SV + ee[q]] = am * (1.f / 7.5f);
            }
        }
    }
}
__device__ __forceinline__ void p0_prologue(Frame& F, const Args& A) {
    const int lane = F.lane, gw = F.vcu * NWAVES + F.wave, NGW = F.G * NWAVES;
    constexpr int PM_ITEMS = 31 * 16;
    if (F.vcu * NWAVES < PM_ITEMS) {
        LAS float* hn = (LAS float*)(F.lds);
#pragma unroll
        for (int rr = 0; rr < 2; ++rr) {
            const int r = 2 * F.wave + rr; float v[16], ss = 0.f;
#pragma unroll
            for (int j = 0; j < 16; ++j) { v[j] = IN_meta[r * 1024 + j * 64 + lane]; ss += v[j] * v[j]; }
            const float rstd = rsqrtf(wave_sum(ss) * (1.f / 1024.f) + EPS);
#pragma unroll
            for (int j = 0; j < 16; ++j) hn[r * 1024 + j * 64 + lane] = v[j] * rstd * IN_norm1_g[j * 64 + lane];
        }
        __syncthreads();
        if (gw < PM_ITEMS) {
            const int cb = gw % 31, kc = gw / 31, col = 64 * cb + lane; const bool ok = col < IN_COLS;
            const float* wp = IN_w_in + (size_t)(64 * kc) * IN_COLS + (ok ? col : 0);
            float acc[16];
#pragma unroll
            for (int r = 0; r < 16; ++r) acc[r] = 0.f;
#pragma unroll 1
            for (int k4 = 0; k4 < 64; k4 += 16) {
                float w[16];
#pragma unroll
                for (int j = 0; j < 16; ++j) w[j] = wp[(size_t)(k4 + j) * IN_COLS];
#pragma unroll
                for (int r = 0; r < 16; ++r) {
#pragma unroll
                    for (int j4 = 0; j4 < 16; j4 += 4) { const f32x4 hv = *(const LAS f32x4*)(hn + r * 1024 + 64 * kc + k4 + j4); acc[r] += (hv.x * w[j4] + hv.y * w[j4 + 1]) + (hv.z * w[j4 + 2] + hv.w * w[j4 + 3]); }
                }
            }
            float* pm = (float*)(F.ws + WS_PMP) + (size_t)kc * (16 * IN_COLS);
            if (ok) {
#pragma unroll
                for (int r = 0; r < 16; ++r) pm[r * IN_COLS + col] = acc[r];
            }
        }
        __syncthreads();
    }
    LAS float* scr = (LAS float*)(F.lds + F.wave * 16384);
    constexpr int I_IN = 16 * 61, I_UQ = 4 * 24, I_UKV = 2 * 32, I_OUT = 16 * 32, I_Q = 16 * 64, NT_ITEMS = I_IN + I_UQ + I_UKV + I_OUT + I_Q;
    for (int it = gw; it < NT_ITEMS; it += NGW) {
        int r = it;
        if (r < I_IN) { p0_transpose_item(IN_w_in, 1024, IN_COLS, IN_norm1_g, WSB(WS_WIN), scr, r, lane); continue; } r -= I_IN;
        if (r < I_UQ) { p0_transpose_item(IN_w_uq, 256, 768, IN_q_norm_g, WSB(WS_WUQ), scr, r, lane); continue; } r -= I_UQ;
        if (r < I_UKV) { p0_transpose_item(IN_w_ukv, 128, 1024, IN_kv_norm_g, WSB(WS_WUKV), scr, r, lane); continue; } r -= I_UKV;
        if (r < I_OUT) { const int kb = r / 32; const float* g = kb < 8 ? IN_attn_out_g : IN_conv_out_g - 512;
                         p0_transpose_item(IN_w_out, 1024, 1024, g, WSB(WS_WOUT), scr, r, lane); continue; } r -= I_OUT;
        p0_transpose_item(IN_w_query, 1024, 2048, IN_norm2_g, WSB(WS_WQ), scr, r, lane);
    }
    for (int it = gw; it < 96; it += NGW) { GAS v4u* d = (GAS v4u*)(WSB(WS_WIN) + (size_t)(IN_COLS + it) * 1024); d[lane] = (v4u){0, 0, 0, 0}; d[64 + lane] = (v4u){0, 0, 0, 0}; }
    for (int it = gw; it < 64; it += NGW) {
        const float* src = (it < 32 ? IN_keys1 : IN_keys2 - 16384) + it * 512 + lane * 8;
        const f32x4 a = *(const GAS f32x4*)src, b = *(const GAS f32x4*)(src + 4);
        v4u o; o.x = pk2(a.x, a.y); o.y = pk2(a.z, a.w); o.z = pk2(b.x, b.y); o.w = pk2(b.z, b.w);
        *(GAS v4u*)(WSB(WS_KEYS) + it * 512 + lane * 8) = o;
    }
    for (int row0 = gw; row0 < M; row0 += 2 * NGW) {
        const int row1 = row0 + NGW; const bool v1 = row1 < M;
        f32x4 xa[2][4];
#pragma unroll
        for (int q = 0; q < 2; ++q) { const GAS f32x4* s4 = (const GAS f32x4*)(IN_x + (size_t)(q == 0 ? row0 : (v1 ? row1 : row0)) * 1024);
            xa[q][0] = __builtin_nontemporal_load(s4 + 2 * lane); xa[q][1] = __builtin_nontemporal_load(s4 + 2 * lane + 1); xa[q][2] = __builtin_nontemporal_load(s4 + 128 + 2 * lane); xa[q][3] = __builtin_nontemporal_load(s4 + 128 + 2 * lane + 1); }
#pragma unroll
        for (int q = 0; q < 2; ++q) {
            float ss = 0.f;
#pragma unroll
            for (int j = 0; j < 4; ++j) ss += (xa[q][j].x * xa[q][j].x + xa[q][j].y * xa[q][j].y) + (xa[q][j].z * xa[q][j].z + xa[q][j].w * xa[q][j].w);
            ss = wave_sum(ss);
            const int row = q == 0 ? row0 : row1;
            if (q == 0 || v1) {
                v4u o0, o1; o0.x = pk2(xa[q][0].x, xa[q][0].y); o0.y = pk2(xa[q][0].z, xa[q][0].w); o0.z = pk2(xa[q][1].x, xa[q][1].y); o0.w = pk2(xa[q][1].z, xa[q][1].w);
                o1.x = pk2(xa[q][2].x, xa[q][2].y); o1.y = pk2(xa[q][2].z, xa[q][2].w); o1.z = pk2(xa[q][3].x, xa[q][3].y); o1.w = pk2(xa[q][3].z, xa[q][3].w);
                GAS v4u* d4 = (GAS v4u*)(WSB(WS_XB) + (size_t)row * 1024); d4[lane] = o0; d4[64 + lane] = o1;
                if (lane == 0) F.sm[SM_RSTD1 + row] = rsqrtf(ss * (1.f / 1024.f) + EPS);
            }
        }
    }
    for (int it = gw * 64 + lane; it < (N_META + SEQ) * 16; it += NGW * 64) {
        const int pos = it >> 4, i = it & 15;
        const float inv = 1.0f / powf(10000.0f, (float)(2 * i) / 32.0f);
        const float ang = (float)pos * inv;
        F.sm[SM_ROPE + pos * 32 + i] = cosf(ang); F.sm[SM_ROPE + pos * 32 + 16 + i] = sinf(ang);
    }
    for (int it = gw; it < BATCH * 48; it += NGW) {
        const int b = it / 48, j = it % 48; const size_t r = (size_t)b * KVROWS + j;
        ((GAS v4u*)(WSB(WS_KN) + r * 512))[lane] = (v4u){0, 0, 0, 0}; ((GAS v4u*)(WSB(WS_VV) + r * 512))[lane] = (v4u){0, 0, 0, 0};
        if (lane < 4) ((GAS v4u*)(WSB(WS_KR) + r * 32))[lane] = (v4u){0, 0, 0, 0};
    }
}

__device__ __forceinline__ float pmeta_sum(const float* pmp, int r, int col) {
    float s = 0.f;
#pragma unroll
    for (int kc = 0; kc < 16; ++kc) s += pmp[(size_t)kc * (16 * IN_COLS) + r * IN_COLS + col];
    return s;
}
__device__ __forceinline__ void p1_meta(Frame& F, const Args& A) {
    const float* pmp = (const float*)(F.ws + WS_PMP);
    if (F.vcu == 32) {
        if (F.tid < 256) {
            const int r = F.tid >> 4, i = F.tid & 15;
            const float c = F.sm[SM_ROPE + r * 32 + i], s = F.sm[SM_ROPE + r * 32 + 16 + i];
            const float x1 = pmeta_sum(pmp, r, O2 + i), x2 = pmeta_sum(pmp, r, O2 + 16 + i);
            const bf16 y1 = (bf16)f2bf(x1 * c - x2 * s), y2 = (bf16)f2bf(x1 * s + x2 * c);
#pragma unroll
            for (int b = 0; b < BATCH; ++b) { const size_t kr = (size_t)b * KVROWS + 48 + r; WSB(WS_KR)[kr * 32 + i] = y1; WSB(WS_KR)[kr * 32 + 16 + i] = y2; }
        }
        for (int idx = F.tid; idx < 1024; idx += 512) { const int i = idx >> 9, c = idx & 511; F.sm[SM_ZMETA + idx] = pmeta_sum(pmp, 14 + i, O4 + c) * pmeta_sum(pmp, 14 + i, O5 + c); }
    }
}
__device__ __forceinline__ void p2_meta_kv(Frame& F, const Args& A, int j) {
    const float* pmp = (const float*)(F.ws + WS_PMP);
    LAS float* st = (LAS float*)F.lds;
    for (int idx = F.tid; idx < 16 * 128; idx += 512) st[idx] = pmeta_sum(pmp, idx >> 7, O1 + (idx & 127));
    __syncthreads();
    if (F.tid < 256) {
        const int r = F.tid >> 4, n = 16 * j + (F.tid & 15);
        const LAS float* ck = st + r * 128;
        float ss = 0.f;
#pragma unroll 16
        for (int k = 0; k < 128; ++k) ss += ck[k] * ck[k];
        const float rstd = rsqrtf(ss * (1.f / 128.f) + EPS);
        float acc = 0.f;
#pragma unroll 32
        for (int k = 0; k < 128; ++k) acc += ck[k] * IN_kv_norm_g[k] * IN_w_ukv[(size_t)k * 1024 + n];
        acc *= rstd;
        const int h = n >> 7, wi = n & 127; const bf16 o = (bf16)f2bf(acc);
#pragma unroll
        for (int b = 0; b < BATCH; ++b) { const size_t kr = (size_t)b * KVROWS + 48 + r; if (wi < 64) WSB(WS_KN)[kr * 512 + h * 64 + wi] = o; else WSB(WS_VV)[kr * 512 + h * 64 + (wi - 64)] = o; }
    }
    __syncthreads();
}

typedef pg8::f32x4 af4;
__device__ __forceinline__ v2u pack4(af4 v) { v2u o; o.x = pg8::cvt_pk_bf16(v[0], v[1]); o.y = pg8::cvt_pk_bf16(v[2], v[3]); return o; }
__device__ __forceinline__ af4 swap32(af4 v) {
    af4 o;
#pragma unroll
    for (int j = 0; j < 4; ++j) { float a = v[j], b = v[j]; asm volatile("s_nop 1\n\tv_permlane32_swap_b32 %0, %1" : "+v"(a), "+v"(b)); o[j] = (lane_id64() & 32) ? a : b; }
    return o;
}
struct EpiInProj {
    static constexpr bool PERM = true, HAS_MID = false; int mid_t;
    bf16* P; const float* rstd1; float* ssqq; float* ssqkv; bf16* KR; const float* rope;
    __device__ __forceinline__ void mid(af4 (&)[2][2][4][2], const pg8::Unit&, int, int, int, int) const {}
    __device__ __forceinline__ void operator()(const af4 (&acc)[2][2][4][2], const pg8::Unit& u, int wr, int wc, int fr, int fq) const {
#pragma unroll
        for (int ai = 0; ai < 2; ++ai)
#pragma unroll
            for (int m = 0; m < 4; ++m) {
                const int row = u.pm * 256 + ai * 128 + wr * 64 + m * 16 + fr; const float rs = rstd1[row];
                float sq = 0.f; af4 v[2][2];
#pragma unroll
                for (int bj = 0; bj < 2; ++bj) {
                    v[bj][0] = acc[ai][bj][m][0] * rs; v[bj][1] = acc[ai][bj][m][1] * rs;
                    const int col = u.pn * 256 + bj * 128 + wc * 32 + 8 * fq;
                    const v2u a = pack4(v[bj][0]), b = pack4(v[bj][1]);
                    *(GAS v4u*)(P + (size_t)row * PN + col) = (v4u){a.x, a.y, b.x, b.y};
                    if (bj == 0 || u.pn == 0) {
#pragma unroll
                        for (int n = 0; n < 2; ++n) sq += (v[bj][n][0] * v[bj][n][0] + v[bj][n][1] * v[bj][n][1]) + (v[bj][n][2] * v[bj][n][2] + v[bj][n][3] * v[bj][n][3]);
                    }
                }
                if (u.pn <= 1) {
                    sq += __shfl_xor(sq, 16); sq += __shfl_xor(sq, 32);
                    if (fq == 0) { if (u.pn == 0) ssqq[row * 4 + wc] = sq; else ssqkv[row * 4 + wc] = sq; }
                }
                if (u.pn == 1 && wc == 0) {
                    const int b = row >> 12, s = row & 4095; const float* rp = rope + (N_META + s) * 32 + 8 * (fq & 1);
                    bf16* kr = KR + ((size_t)b * KVROWS + 64 + s) * 32 + 8 * fq;
#pragma unroll
                    for (int n = 0; n < 2; ++n) {
                        const af4 c = *(const GAS af4*)(rp + 4 * n), sn = *(const GAS af4*)(rp + 16 + 4 * n);
                        const af4 mine = v[1][n], oth = swap32(mine);
                        const af4 y = (fq < 2) ? (mine * c - oth * sn) : (oth * sn + mine * c);
                        *(GAS v2u*)(kr + 4 * n) = pack4(y);
                    }
                }
            }
    }
};
struct EpiKV {
    static constexpr bool PERM = true, HAS_MID = false; int mid_t;
    bf16* KN; bf16* VV; const float* ssqkv;
    __device__ __forceinline__ void mid(af4 (&)[2][2][4][2], const pg8::Unit&, int, int, int, int) const {}
    __device__ __forceinline__ void operator()(const af4 (&acc)[2][2][4][2], const pg8::Unit& u, int wr, int wc, int fr, int fq) const {
        bf16* dst = wc < 2 ? KN : VV;
#pragma unroll
        for (int ai = 0; ai < 2; ++ai)
#pragma unroll
            for (int m = 0; m < 4; ++m) {
                const int row = u.pm * 256 + ai * 128 + wr * 64 + m * 16 + fr;
                const af4 q = *(const GAS af4*)(ssqkv + row * 4);
                const float rs = rsqrtf(((q[0] + q[1]) + (q[2] + q[3])) * (1.f / 128.f) + EPS);
                const size_t kr = (size_t)(row >> 12) * KVROWS + 64 + (row & 4095);
#pragma unroll
                for (int bj = 0; bj < 2; ++bj) {
                    const int h = u.pn * 2 + bj;
                    const af4 v0 = acc[ai][bj][m][0] * rs, v1 = acc[ai][bj][m][1] * rs;
                    const v2u a = pack4(v0), b = pack4(v1);
                    *(GAS v4u*)(dst + kr * 512 + h * 64 + (wc & 1) * 32 + 8 * fq) = (v4u){a.x, a.y, b.x, b.y};
                }
            }
    }
};
struct EpiQ {
    static constexpr bool PERM = false, HAS_MID = false; int mid_t;
    bf16* Q; const float* ssqq; const float* rope;
    __device__ __forceinline__ void mid(af4 (&)[2][2][4][2], const pg8::Unit&, int, int, int, int) const {}
    __device__ __forceinline__ void operator()(const af4 (&acc)[2][2][4][2], const pg8::Unit& u, int wr, int wc, int fr, int fq) const {
#pragma unroll
        for (int ai = 0; ai < 2; ++ai)
#pragma unroll
            for (int m = 0; m < 4; ++m) {
                const int row = u.pm * 256 + ai * 128 + wr * 64 + m * 16 + fr;
                const af4 q = *(const GAS af4*)(ssqq + row * 4);
                const float rs = rsqrtf(((q[0] + q[1]) + (q[2] + q[3])) * (1.f / 256.f) + EPS) * QSCALE;
                const float* rp = rope + (N_META + (row & 4095)) * 32 + 4 * fq;
                const af4 c = *(const GAS af4*)rp, sn = *(const GAS af4*)(rp + 16);
#pragma unroll
                for (int bj = 0; bj < 2; ++bj) {
                    const int g = u.pn * 8 + bj * 4 + wc;
                    af4 v0 = acc[ai][bj][m][0] * rs, v1 = acc[ai][bj][m][1] * rs;
                    if (g % 3 == 2) { const af4 y1 = v0 * c - v1 * sn, y2 = v0 * sn + v1 * c; v0 = y1; v1 = y2; }
                    bf16* qp = Q + (size_t)row * 768 + g * 32 + 4 * fq;
                    *(GAS v2u*)qp = pack4(v0); *(GAS v2u*)(qp + 16) = pack4(v1);
                }
            }
    }
};
struct EpiOut {
    static constexpr bool PERM = true, HAS_MID = true; int mid_t;
    bf16* H2b; float* ssq2; const LAS float* tab;
    __device__ __forceinline__ void mid(af4 (&acc)[2][2][4][2], const pg8::Unit&, int wr, int, int fr, int) const {
#pragma unroll
        for (int ai = 0; ai < 2; ++ai)
#pragma unroll
            for (int m = 0; m < 4; ++m) { const float f = tab[ai * 128 + wr * 64 + m * 16 + fr];
#pragma unroll
                for (int bj = 0; bj < 2; ++bj)
#pragma unroll
                    for (int n = 0; n < 2; ++n) acc[ai][bj][m][n] = acc[ai][bj][m][n] * f; }
    }
    __device__ __forceinline__ void operator()(const af4 (&acc)[2][2][4][2], const pg8::Unit& u, int wr, int wc, int fr, int fq) const {
#pragma unroll
        for (int ai = 0; ai < 2; ++ai)
#pragma unroll
            for (int m = 0; m < 4; ++m) {
                const int row = u.pm * 256 + ai * 128 + wr * 64 + m * 16 + fr; float sq = 0.f;
#pragma unroll
                for (int bj = 0; bj < 2; ++bj) {
                    const int col = u.pn * 256 + bj * 128 + wc * 32 + 8 * fq;
                    const v4u xw = *(const GAS v4u*)(H2b + (size_t)row * 1024 + col);
                    const af4 x0 = {bf_lo(xw.x), bf_hi(xw.x), bf_lo(xw.y), bf_hi(xw.y)}, x1 = {bf_lo(xw.z), bf_hi(xw.z), bf_lo(xw.w), bf_hi(xw.w)};
                    const af4 v0 = acc[ai][bj][m][0] + x0, v1 = acc[ai][bj][m][1] + x1;
                    sq += (v0[0] * v0[0] + v0[1] * v0[1]) + (v0[2] * v0[2] + v0[3] * v0[3]) + (v1[0] * v1[0] + v1[1] * v1[1]) + (v1[2] * v1[2] + v1[3] * v1[3]);
                    const v2u a = pack4(v0), b = pack4(v1);
                    *(GAS v4u*)(H2b + (size_t)row * 1024 + col) = (v4u){a.x, a.y, b.x, b.y};
                }
                sq += __shfl_xor(sq, 16); sq += __shfl_xor(sq, 32);
                if (fq == 0) ssq2[row * 16 + u.pn * 4 + wc] = sq;
            }
    }
};
struct EpiQp {
    static constexpr bool PERM = true, HAS_MID = false; int mid_t;
    bf16* Qp;
    __device__ __forceinline__ void mid(af4 (&)[2][2][4][2], const pg8::Unit&, int, int, int, int) const {}
    __device__ __forceinline__ void operator()(const af4 (&acc)[2][2][4][2], const pg8::Unit& u, int wr, int wc, int fr, int fq) const {
#pragma unroll
        for (int ai = 0; ai < 2; ++ai)
#pragma unroll
            for (int m = 0; m < 4; ++m) {
                const int row = u.pm * 256 + ai * 128 + wr * 64 + m * 16 + fr;
#pragma unroll
                for (int bj = 0; bj < 2; ++bj) {
                    const int col = u.pn * 256 + bj * 128 + wc * 32 + 8 * fq;
                    const v2u a = pack4(acc[ai][bj][m][0]), b = pack4(acc[ai][bj][m][1]);
                    *(GAS v4u*)(Qp + (size_t)row * 2048 + col) = (v4u){a.x, a.y, b.x, b.y};
                }
            }
    }
};

__device__ __forceinline__ void unpack8(v4u w, float (&f)[8]) { f[0] = bf_lo(w.x); f[1] = bf_hi(w.x); f[2] = bf_lo(w.y); f[3] = bf_hi(w.y); f[4] = bf_lo(w.z); f[5] = bf_hi(w.z); f[6] = bf_lo(w.w); f[7] = bf_hi(w.w); }
__device__ __forceinline__ void conv_z(const bf16* prow, int c, float (&z)[8]) {
    float a[8], b[8]; unpack8(*(const GAS v4u*)(prow + O4 + c), a); unpack8(*(const GAS v4u*)(prow + O5 + c), b);
#pragma unroll
    for (int j = 0; j < 8; ++j) z[j] = a[j] * b[j];
}
__device__ __forceinline__ void p2_conv(Frame& F, const Args& A) {
    const int lane = F.lane, gw = F.vcu * NWAVES + F.wave, NGW = F.G * NWAVES, c = 8 * lane;
    float w0[8], w1[8], w2[8], cb[8];
#pragma unroll
    for (int j = 0; j < 8; ++j) { w0[j] = IN_conv_w[c + j]; w1[j] = IN_conv_w[512 + c + j]; w2[j] = IN_conv_w[1024 + c + j]; cb[j] = IN_conv_b[c + j]; }
    for (int ch = gw; ch < M / 8; ch += NGW) {
        const int r0 = ch * 8;
        float z1[8], z2[8];
        if ((r0 & 4095) == 0) {
#pragma unroll
            for (int j = 0; j < 8; ++j) { z2[j] = F.sm[SM_ZMETA + c + j]; z1[j] = F.sm[SM_ZMETA + 512 + c + j]; }
        } else { conv_z(WSB(WS_P) + (size_t)(r0 - 2) * PN, c, z2); conv_z(WSB(WS_P) + (size_t)(r0 - 1) * PN, c, z1); }
        v4u ld_c[8], ld_u[8], ld_b[8];
#pragma unroll
        for (int i = 0; i < 8; ++i) { const bf16* prow = WSB(WS_P) + (size_t)(r0 + i) * PN;
            ld_c[i] = *(const GAS v4u*)(prow + O4 + c); ld_u[i] = *(const GAS v4u*)(prow + O5 + c); ld_b[i] = *(const GAS v4u*)(prow + O3 + c); }
#pragma unroll
        for (int i = 0; i < 8; ++i) {
            const int row = r0 + i;
            float z0[8], bg[8], o[8], ss = 0.f;
            { float a[8], b[8]; unpack8(ld_c[i], a); unpack8(ld_u[i], b);
#pragma unroll
              for (int j = 0; j < 8; ++j) z0[j] = a[j] * b[j]; }
            unpack8(ld_b[i], bg);
#pragma unroll
            for (int j = 0; j < 8; ++j) { o[j] = bg[j] * (cb[j] + w0[j] * z2[j] + w1[j] * z1[j] + w2[j] * z0[j]); ss += o[j] * o[j]; }
            const float rstd = rsqrtf(wave_sum(ss) * (1.f / 512.f) + EPS);
            v4u w; w.x = pk2(o[0] * rstd, o[1] * rstd); w.y = pk2(o[2] * rstd, o[3] * rstd); w.z = pk2(o[4] * rstd, o[5] * rstd); w.w = pk2(o[6] * rstd, o[7] * rstd);
            *(GAS v4u*)(WSB(WS_MIX) + (size_t)row * 1024 + 512 + c) = w;
#pragma unroll
            for (int j = 0; j < 8; ++j) { z2[j] = z1[j]; z1[j] = z0[j]; }
        }
    }
}
__device__ __forceinline__ void p3_attn_simple(Frame& F) {
    LAS float* Qs = (LAS float*)F.lds;
    LAS float* Kt = Qs + 32 * 96;
    LAS float* Vs = Kt + 96 * 65;
    LAS float* Ps = Vs + 64 * 64;
    const bf16 *Q = WSB(WS_Q), *KN = WSB(WS_KN), *VV = WSB(WS_VV), *KR = WSB(WS_KR); bf16* MIX = WSB(WS_MIX); float* ssqatt = F.sm + SM_SSQATT;
    const int tid = F.tid, lane = F.lane, w = F.wave;
    for (int item = F.vcu; item < (SEQ / 32) * 8 * BATCH; item += F.G) {
        const int s0 = (item & 127) * 32, h = (item >> 7) & 7, b = item >> 10;
        const size_t kb = (size_t)b * KVROWS;
        __syncthreads();
        for (int idx = tid; idx < 32 * 96; idx += 512) { const int r = idx / 96, d = idx % 96; Qs[r * 96 + d] = bf2f(Q[((size_t)b * SEQ + s0 + r) * 768 + h * 96 + d]); }
        float m[4], l[4], o[4];
#pragma unroll
        for (int r = 0; r < 4; ++r) { m[r] = -1e30f; l[r] = 0.f; o[r] = 0.f; }
        const int nt = (64 + s0 + 31) / 64 + 1;
        for (int kt = 0; kt < nt; ++kt) {
            const int k0 = kt * 64;
            __syncthreads();
            for (int idx = tid; idx < 64 * 96; idx += 512) {
                const int key = idx / 96, d = idx % 96, kp = k0 + key;
                float v = 0.f;
                if (kp < KVROWS) v = d < 64 ? bf2f(KN[(kb + kp) * 512 + h * 64 + d]) : bf2f(KR[(kb + kp) * 32 + (d - 64)]);
                Kt[d * 65 + key] = v;
            }
            for (int idx = tid; idx < 64 * 64; idx += 512) {
                const int key = idx >> 6, d = idx & 63, kp = k0 + key;
                Vs[key * 64 + d] = kp < KVROWS ? bf2f(VV[(kb + kp) * 512 + h * 64 + d]) : 0.f;
            }
            __syncthreads();
#pragma unroll
            for (int r = 0; r < 4; ++r) {
                const int row = w * 4 + r, sq = s0 + row, kp = k0 + lane;
                const bool vis = (kp >= 48) && (kp <= 64 + sq);
                float s = 0.f;
                for (int d = 0; d < 96; ++d) s += Qs[row * 96 + d] * Kt[d * 65 + lane];
                if (!vis) s = -1e30f;
                const float mn = fmaxf(m[r], wave_max(s));
                const float pv = vis ? exp2f(s - mn) : 0.f;
                const float corr = exp2f(m[r] - mn);
                l[r] = l[r] * corr + wave_sum(pv);
                m[r] = mn;
                Ps[row * 64 + lane] = pv;
                LDS_WAIT();
                float acc = 0.f;
                for (int k = 0; k < 64; ++k) acc += Ps[row * 64 + k] * Vs[k * 64 + lane];
                o[r] = o[r] * corr + acc;
            }
        }
#pragma unroll
        for (int r = 0; r < 4; ++r) {
            const size_t row = (size_t)b * SEQ + s0 + w * 4 + r;
            const float ov = o[r] / l[r];
            MIX[row * 1024 + h * 64 + lane] = (bf16)f2bf(ov);
            const float ss = wave_sum(ov * ov);
            if (lane == 0) ssqatt[row * 8 + h] = ss;
        }
    }
    __syncthreads();
}

__device__ __forceinline__ void wave_argmax(float& v, int& i) {
#pragma unroll
    for (int o = 32; o >= 1; o >>= 1) {
        const float ov = __shfl_xor(v, o); const int oi = __shfl_xor(i, o);
        if (ov > v || (ov == v && oi < i)) { v = ov; i = oi; }
    }
}
__device__ __forceinline__ void top16_of_128(float a0, float a1, int lane, float& tv, int& ti) {
    tv = 0.f; ti = 0;
    for (int k = 0; k < 16; ++k) {
        float bv; int bi;
        if (a0 >= a1) { bv = a0; bi = lane; } else { bv = a1; bi = lane + 64; }
        wave_argmax(bv, bi);
        if (lane == k) { tv = bv; ti = bi; }
        if (bi == lane) a0 = -4e30f;
        if (bi == lane + 64) a1 = -4e30f;
    }
}
__device__ __forceinline__ void p5_topk_simple(Frame& F, const Args& A) {
    const bf16* Qp = WSB(WS_P); const float *keys1 = IN_keys1, *keys2 = IN_keys2, *ssq2 = F.sm + SM_SSQ2; int* IDX = (int*)(F.ws + WS_IDX); float* GATE = (float*)(F.ws + WS_GATE);
    const int lane = F.lane;
    for (int item = F.vcu * NWAVES + F.wave; item < M * 8; item += F.G * NWAVES) {
    const int row = item >> 3, head = item & 7;
    const bf16* q = Qp + (size_t)row * 2048 + head * 256;
    float rs = 0.f;
#pragma unroll
    for (int j = 0; j < 16; ++j) rs += ssq2[row * 16 + j];
    const float rstd = rsqrtf(rs * (1.f / 1024.f) + EPS);
    float s10 = 0.f, s11 = 0.f, s20 = 0.f, s21 = 0.f;
    for (int k = 0; k < 128; ++k) {
        const float q1 = bf2f(q[k]), q2 = bf2f(q[128 + k]);
        s10 += q1 * keys1[lane * 128 + k]; s11 += q1 * keys1[(64 + lane) * 128 + k];
        s20 += q2 * keys2[lane * 128 + k]; s21 += q2 * keys2[(64 + lane) * 128 + k];
    }
    float tv1, tv2; int ti1, ti2;
    top16_of_128(s10 * rstd, s11 * rstd, lane, tv1, ti1);
    top16_of_128(s20 * rstd, s21 * rstd, lane, tv2, ti2);
    const float vb = __shfl(tv2, lane & 15);
    float c0 = __shfl(tv1, (lane >> 4) + 0) + vb, c1 = __shfl(tv1, (lane >> 4) + 4) + vb;
    float c2 = __shfl(tv1, (lane >> 4) + 8) + vb, c3 = __shfl(tv1, (lane >> 4) + 12) + vb;
    float bestv = 0.f; int besti = 0;
    for (int k = 0; k < 16; ++k) {
        float bv = c0; int bi = lane;
        if (c1 > bv) { bv = c1; bi = lane + 64; }
        if (c2 > bv) { bv = c2; bi = lane + 128; }
        if (c3 > bv) { bv = c3; bi = lane + 192; }
        wave_argmax(bv, bi);
        if (lane == k) { bestv = bv; besti = bi; }
        if (bi == lane) c0 = -4e30f;
        if (bi == lane + 64) c1 = -4e30f;
        if (bi == lane + 128) c2 = -4e30f;
        if (bi == lane + 192) c3 = -4e30f;
    }
    const float mx = __shfl(bestv, 0);
    const float e = lane < 16 ? __expf(bestv - mx) : 0.f;
    const float sum = wave_sum(e);
    const int i1 = __shfl(ti1, (besti >> 4) & 15), i2 = __shfl(ti2, besti & 15);
    if (lane < 16) { IDX[(size_t)row * 128 + head * 16 + lane] = i1 * 128 + i2; GATE[(size_t)row * 128 + head * 16 + lane] = e / sum; }
    }
}

__device__ __forceinline__ float gelu_tanh(float x) {
    const float u = 0.7978845608028654f * (x + 0.044715f * x * x * x);
    return 0.5f * x * (1.f + tanhf(u));
}
__device__ __forceinline__ void p6_gather_simple(Frame& F, const Args& A) {
    const bf16 *H2b = WSB(WS_XB), *U = WSB(WS_U), *V = WSB(WS_V); const float *ssq2 = F.sm + SM_SSQ2, *fg = IN_final_g; const int* IDX = (const int*)(F.ws + WS_IDX); const float* GATE = (const float*)(F.ws + WS_GATE); float* out = A.out;
    const int lane = F.lane;
    for (int t = F.vcu * NWAVES + F.wave; t < M; t += F.G * NWAVES) {
    float h2[16], acc[16];
    { float a[8], b[8]; unpack8(*(const GAS v4u*)(H2b + (size_t)t * 1024 + 8 * lane), a); unpack8(*(const GAS v4u*)(H2b + (size_t)t * 1024 + 512 + 8 * lane), b);
#pragma unroll
      for (int j = 0; j < 8; ++j) { h2[j] = a[j]; h2[8 + j] = b[j]; } }
    float rs = 0.f;
#pragma unroll
    for (int j = 0; j < 16; ++j) { rs += ssq2[t * 16 + j]; acc[j] = 0.f; }
    const float rstd = rsqrtf(rs * (1.f / 1024.f) + EPS);
    for (int hk = 0; hk < 128; ++hk) {
        const int e = IDX[(size_t)t * 128 + hk];
        const float g = GATE[(size_t)t * 128 + hk];
        float ua[8], ub[8], va[8], vb[8];
        unpack8(*(const GAS v4u*)(U + (size_t)e * 1024 + 8 * lane), ua); unpack8(*(const GAS v4u*)(U + (size_t)e * 1024 + 512 + 8 * lane), ub);
        unpack8(*(const GAS v4u*)(V + (size_t)e * 1024 + 8 * lane), va); unpack8(*(const GAS v4u*)(V + (size_t)e * 1024 + 512 + 8 * lane), vb);
        float d = 0.f;
#pragma unroll
        for (int j = 0; j < 8; ++j) d += h2[j] * ua[j] + h2[8 + j] * ub[j];
        d = wave_sum(d) * rstd;
        const float coef = g * gelu_tanh(d);
#pragma unroll
        for (int j = 0; j < 8; ++j) { acc[j] += coef * va[j]; acc[8 + j] += coef * vb[j]; }
    }
    float ss = 0.f;
#pragma unroll
    for (int j = 0; j < 16; ++j) { acc[j] += h2[j]; ss += acc[j] * acc[j]; }
    const float r2 = rsqrtf(wave_sum(ss) * (1.f / 1024.f) + EPS);
    const f32x4 g0 = *(const GAS f32x4*)(fg + 8 * lane), g1 = *(const GAS f32x4*)(fg + 8 * lane + 4), g2 = *(const GAS f32x4*)(fg + 512 + 8 * lane), g3 = *(const GAS f32x4*)(fg + 512 + 8 * lane + 4);
    float* o = out + (size_t)t * 1024;
    *(GAS f32x4*)(o + 8 * lane) = (f32x4){acc[0] * r2 * g0.x, acc[1] * r2 * g0.y, acc[2] * r2 * g0.z, acc[3] * r2 * g0.w};
    *(GAS f32x4*)(o + 8 * lane + 4) = (f32x4){acc[4] * r2 * g1.x, acc[5] * r2 * g1.y, acc[6] * r2 * g1.z, acc[7] * r2 * g1.w};
    *(GAS f32x4*)(o + 512 + 8 * lane) = (f32x4){acc[8] * r2 * g2.x, acc[9] * r2 * g2.y, acc[10] * r2 * g2.z, acc[11] * r2 * g2.w};
    *(GAS f32x4*)(o + 512 + 8 * lane + 4) = (f32x4){acc[12] * r2 * g3.x, acc[13] * r2 * g3.y, acc[14] * r2 * g3.z, acc[15] * r2 * g3.w};
    }
}
__device__ __forceinline__ float gelu_fast(float x) {
    const float u = 0.7978845608028654f * (x + 0.044715f * x * x * x);
    const float e = __expf(2.f * u);
    return 0.5f * x * (2.f - 2.f / (e + 1.f));
}
template <int K> __device__ __forceinline__ int xswz(int v) { return __builtin_amdgcn_ds_swizzle(v, (K << 10) | 0x1F); }
__device__ __forceinline__ int sum_xor32(int v) { return v + ix32(v); }
#define G_ISSUE(buf, tbl, ireg, lbase) do { _Pragma("unroll") for (int r_ = 0; r_ < 16; ++r_) { \
        const unsigned e_ = (unsigned)__builtin_amdgcn_readlane((int)(ireg), (lbase) + r_); \
        const unsigned char* rp_ = (tbl) + ((size_t)e_ << 10); asm volatile("" : "+s"(rp_));     \
        buf[r_] = *(const GAS v4u*)(rp_ + voff); } } while (0)
#define G_DOTS(buf, d) do { _Pragma("unroll") for (int r_ = 0; r_ < 16; ++r_) { int s_ = __builtin_amdgcn_sdot4((int)buf[r_].x, hq0, 0, false); \
        s_ = __builtin_amdgcn_sdot4((int)buf[r_].y, hq1, s_, false); s_ = __builtin_amdgcn_sdot4((int)buf[r_].z, hq2, s_, false); d[r_] = __builtin_amdgcn_sdot4((int)buf[r_].w, hq3, s_, false); } } while (0)
#define G_AXW(w, k) do { acc[k] += c_ * (float)((w) & 255u); acc[(k) + 1] += c_ * (float)(((w) >> 8) & 255u); acc[(k) + 2] += c_ * (float)(((w) >> 16) & 255u); acc[(k) + 3] += c_ * (float)((w) >> 24); } while (0)
#define G_AXPY(buf, creg, lbase) do { _Pragma("unroll") for (int r_ = 0; r_ < 16; ++r_) { \
        const float c_ = __builtin_bit_cast(float, __builtin_amdgcn_readlane(__builtin_bit_cast(int, creg), (lbase) + r_)); \
        G_AXW(buf[r_].x, 0); G_AXW(buf[r_].y, 4); G_AXW(buf[r_].z, 8); G_AXW(buf[r_].w, 12); } } while (0)
template <int CTRL> __device__ __forceinline__ int gdpp(int v) { return __builtin_amdgcn_update_dpp(0, v, CTRL, 0xF, 0xF, false); }
__device__ __forceinline__ int gsum_rows(int v) {
    int a = v, b = v; asm volatile("s_nop 1\n\tv_permlane16_swap_b32 %0, %1" : "+v"(a), "+v"(b)); a += b; b = a;
    asm volatile("s_nop 1\n\tv_permlane32_swap_b32 %0, %1" : "+v"(a), "+v"(b)); return a + b;
}
#define G_REDUCE(d, out) do { int e8_[8], e4_[4], e2_[2], e1_; \
        { const bool b_ = lane & 8; _Pragma("unroll") for (int i_ = 0; i_ < 8; ++i_) { const int keep_ = b_ ? d[i_ + 8] : d[i_], send_ = b_ ? d[i_] : d[i_ + 8]; e8_[i_] = keep_ + gdpp<0x128>(send_); } } \
        { const bool b_ = lane & 4; _Pragma("unroll") for (int i_ = 0; i_ < 4; ++i_) { const int keep_ = b_ ? e8_[i_ + 4] : e8_[i_], send_ = b_ ? e8_[i_] : e8_[i_ + 4]; e4_[i_] = keep_ + gdpp<0x141>(send_); } } \
        { const bool b_ = lane & 2; _Pragma("unroll") for (int i_ = 0; i_ < 2; ++i_) { const int keep_ = b_ ? e4_[i_ + 2] : e4_[i_], send_ = b_ ? e4_[i_] : e4_[i_ + 2]; e2_[i_] = keep_ + gdpp<0x4E>(send_); } } \
        { const bool b_ = lane & 1; const int keep_ = b_ ? e2_[1] : e2_[0], send_ = b_ ? e2_[0] : e2_[1]; e1_ = keep_ + gdpp<0xB1>(send_); } \
        out = gsum_rows(e1_); } while (0)
#define G_REDUCE8(d, out) do { int e4_[4], e2_[2], e1_; \
        { const bool b_ = lane & 4; _Pragma("unroll") for (int i_ = 0; i_ < 4; ++i_) { const int keep_ = b_ ? d[i_ + 4] : d[i_], send_ = b_ ? d[i_] : d[i_ + 4]; e4_[i_] = keep_ + gdpp<0x141>(send_); } } \
        { const bool b_ = lane & 2; _Pragma("unroll") for (int i_ = 0; i_ < 2; ++i_) { const int keep_ = b_ ? e4_[i_ + 2] : e4_[i_], send_ = b_ ? e4_[i_] : e4_[i_ + 2]; e2_[i_] = keep_ + gdpp<0x4E>(send_); } } \
        { const bool b_ = lane & 1; const int keep_ = b_ ? e2_[1] : e2_[0], send_ = b_ ? e2_[0] : e2_[1]; e1_ = keep_ + gdpp<0xB1>(send_); } \
        e1_ += gdpp<0x128>(e1_); out = gsum_rows(e1_); } while (0)
#define G_TOUCH16(b) asm volatile("" :: "v"(b[0]), "v"(b[1]), "v"(b[2]), "v"(b[3]), "v"(b[4]), "v"(b[5]), "v"(b[6]), "v"(b[7]), "v"(b[8]), "v"(b[9]), "v"(b[10]), "v"(b[11]), "v"(b[12]), "v"(b[13]), "v"(b[14]), "v"(b[15]))
#define G_TOUCH12(b) asm volatile("" :: "v"(b[0]), "v"(b[1]), "v"(b[2]), "v"(b[3]), "v"(b[4]), "v"(b[5]), "v"(b[6]), "v"(b[7]), "v"(b[8]), "v"(b[9]), "v"(b[10]), "v"(b[11]))
#define GL_SE(ts)   (wl + (ts) * 128)
#define GL_CO(ts)   (wl + 1024 + (ts) * 128)
#define GL_DS(ts)   (wl + 2048 + (ts) * 128)
#define GL_DSC      (wl + 3080)
__device__ __forceinline__ int gdot4z(int a, int b) { int r; asm("v_dot4_i32_i8 %0, %1, %2, 0" : "=v"(r) : "v"(a), "v"(b)); return r; }
#define GU_LD1(buf, s_) { const unsigned e_ = (unsigned)__builtin_amdgcn_readlane(ev_, s_);     \
            if constexpr (!(PROBE & 4)) buf[s_] = *(const GAS v4u*)(U + ((e_ << 10) + voff)); }
#define GU_EV(c_, ts_) const int poff_ = __builtin_amdgcn_readlane(offv[ts_], (c_)), pn_ = __builtin_amdgcn_readlane(offv[ts_], (c_) + 1) - poff_; \
        const int ev_ = (wl + ((poff_ + l15) & 127))[(ts_) * 128];
#define GU_ISSUE2(buf) do { const int n_ = pn_; \
        if (n_ >= 8) { _Pragma("unroll") for (int s_ = 0; s_ < 8; ++s_) GU_LD1(buf, s_) _Pragma("unroll") for (int s_ = 8; s_ < 16; ++s_) { if (s_ < n_) GU_LD1(buf, s_) } } \
        else { _Pragma("unroll") for (int s_ = 0; s_ < 8; ++s_) { if (s_ < n_) GU_LD1(buf, s_) } } } while (0)
#define GU_PREP(buf, c_, ts_) do { GU_EV(c_, ts_) GU_ISSUE2(buf); } while (0)
#define GU_STEPM(cur, nxt, cn_, tn_, cc_, tc_) { GU_EV(cn_, tn_) __builtin_amdgcn_sched_barrier(0); G_TOUCH16(cur); __builtin_amdgcn_sched_barrier(0); GU_ISSUE2(nxt); __builtin_amdgcn_sched_barrier(0); \
        GU_COMP(cur, cc_, tc_); su_off = poff_; su_n = pn_; __builtin_amdgcn_sched_barrier(0); }
#define GU_DOT16(buf, ts_, d) do { _Pragma("unroll") for (int s_ = 0; s_ < 16; ++s_) { int q_ = gdot4z((int)buf[s_].x, hq[ts_][0]); q_ = __builtin_amdgcn_sdot4((int)buf[s_].y, hq[ts_][1], q_, false); \
        q_ = __builtin_amdgcn_sdot4((int)buf[s_].z, hq[ts_][2], q_, false); d[s_] = __builtin_amdgcn_sdot4((int)buf[s_].w, hq[ts_][3], q_, false); } } while (0)
#define GU_DOT8(buf, ts_, d) do { _Pragma("unroll") for (int s_ = 0; s_ < 8; ++s_) { int q_ = gdot4z((int)buf[s_].x, hq[ts_][0]); q_ = __builtin_amdgcn_sdot4((int)buf[s_].y, hq[ts_][1], q_, false); \
        q_ = __builtin_amdgcn_sdot4((int)buf[s_].z, hq[ts_][2], q_, false); d[s_] = __builtin_amdgcn_sdot4((int)buf[s_].w, hq[ts_][3], q_, false); } } while (0)
#define GU_COMP(buf, c_, ts_) do { const int off_ = su_off, n_ = su_n;                  \
        int d_[16], r_; if constexpr (!(PROBE & 8)) { if (n_ <= 8) { GU_DOT8(buf, ts_, d_); G_REDUCE8(d_, r_); } else { GU_DOT16(buf, ts_, d_); G_REDUCE(d_, r_); } \
            { LAS int* wt_ = wl + off_ + lane; asm volatile("" : "+v"(wt_)); if (lane < 16 && lane < n_) wt_[2048 + (ts_) * 128] = r_; } } \
        for (int b_ = 16; b_ < n_; b_ += 16) {                                   \
            const int ev2_ = (wl + ((off_ + b_ + l15) & 127))[(ts_) * 128];              \
            _Pragma("unroll") for (int s_ = 0; s_ < 16; ++s_) { if (b_ + s_ < n_) { const unsigned e_ = (unsigned)__builtin_amdgcn_readlane(ev2_, s_); \
                const unsigned char* rp_ = U + ((size_t)e_ << 10); asm volatile("" : "+s"(rp_)); buf[s_] = *(const GAS v4u*)(rp_ + voff); } } \
            GU_DOT16(buf, ts_, d_); G_REDUCE(d_, r_); { LAS int* wt_ = wl + off_ + b_ + lane; asm volatile("" : "+v"(wt_)); if (lane < 16 && b_ + lane < n_) wt_[2048 + (ts_) * 128] = r_; } } } while (0)
#define GV_PAIRS 6
typedef _Float16 gh2 __attribute__((ext_vector_type(2)));
typedef int gv16i __attribute__((ext_vector_type(16)));
#define GV_STEP(c_, ts_) const int off_ = __builtin_amdgcn_readlane(offv[ts_], (c_)), n_ = __builtin_amdgcn_readlane(offv[ts_], (c_) + 1) - off_, h0_ = (n_ + 1) >> 1; \
        const int cfix_ = (half & n_) ? 0 : -1; const LAS int* sb_ = wl + (ts_) * 128 + off_ + (half ? n_ - h0_ : 0);
__device__ __forceinline__ unsigned gmad24(unsigned e, unsigned m, unsigned a) { unsigned r; asm("v_mad_u32_u24 %0, %1, %2, %3" : "=v"(r) : "v"(e), "s"(m), "v"(a)); return r; }
#define GV_IDS(E, base_) _Pragma("unroll") for (int q_ = 0; q_ < GV_PAIRS; ++q_) E[q_] = sb_[(base_) + q_];
#define GV_ISSUE(bufa, bufb, E, base_) do { \
        _Pragma("unroll") for (int q_ = 0; q_ < GV_PAIRS; ++q_) { if ((base_) + q_ < h0_) { const unsigned ee_ = (unsigned)E[q_]; \
            if constexpr (!(PROBE & 16)) { bufa[q_] = *(const GAS v4u*)(V + gmad24(ee_, 768u, voff6a)); bufb[q_] = *(const GAS v2u*)(V + gmad24(ee_, 768u, voff6b)); } else { bufa[q_].x ^= ee_; } } } } while (0)
#define GV_PREP(bufa, bufb, c_, ts_) do { GV_STEP(c_, ts_) int e_[GV_PAIRS]; GV_IDS(e_, 0) GV_ISSUE(bufa, bufb, e_, 0); } while (0)
#define GV_CWS(CW, base_) _Pragma("unroll") for (int q_ = 0; q_ < GV_PAIRS; ++q_) CW[q_] = sb_[1024 + (base_) + q_];
#define GV_ROWS(bufa, bufb, A_, CW, base_) do { \
        if constexpr (!(PROBE & 32)) _Pragma("unroll") for (int q_ = 0; q_ < GV_PAIRS; ++q_) { if ((base_) + q_ < h0_) { \
            const int cz_ = CW[q_]; const gh2 c_ = __builtin_bit_cast(gh2, cz_); \
            const v6u pk_ = {bufa[q_].x, bufa[q_].y, bufa[q_].z, bufa[q_].w, bufb[q_].x, bufb[q_].y}; \
            const v32h x_ = __builtin_amdgcn_cvt_scalef32_pk32_f16_fp6(pk_, 1.0f); const gv16i xi_ = __builtin_bit_cast(gv16i, x_); \
            _Pragma("unroll") for (int k_ = 0; k_ < 16; ++k_) { const int xe_ = xi_[k_]; A_[k_] = c_ * __builtin_bit_cast(gh2, xe_) + A_[k_]; } } } } while (0)
#define GV_STEPM(ca, cb, na, nb, cn_, tn_, cc_, tc_, A_) { int e_[GV_PAIRS], cw_[GV_PAIRS]; int nh0_, ncfix_; const LAS int* nsb_; \
        { GV_STEP(cn_, tn_) GV_IDS(e_, 0) nh0_ = h0_; ncfix_ = cfix_; nsb_ = sb_; } \
        { const int h0_ = s_h0; const LAS int* sb_ = s_sb; GV_CWS(cw_, 0) \
          __builtin_amdgcn_sched_barrier(0); GV_TOUCH(ca, cb); __builtin_amdgcn_sched_barrier(0); \
          { const int h0_ = nh0_; GV_ISSUE(na, nb, e_, 0); } __builtin_amdgcn_sched_barrier(0); \
          cw_[0] &= s_cfix; \
          GV_ROWS(ca, cb, A_, cw_, 0); \
          for (int b_ = GV_PAIRS; b_ < h0_; b_ += GV_PAIRS) {                              \
              int e2_[GV_PAIRS], cw2_[GV_PAIRS]; GV_IDS(e2_, b_) GV_CWS(cw2_, b_) GV_ISSUE(ca, cb, e2_, b_); GV_ROWS(ca, cb, A_, cw2_, b_); } } \
        s_h0 = nh0_; s_cfix = ncfix_; s_sb = nsb_; \
        __builtin_amdgcn_sched_barrier(0); }
#define GV_PREP0(bufa, bufb, c_, ts_) do { GV_STEP(c_, ts_) int e_[GV_PAIRS]; GV_IDS(e_, 0) GV_ISSUE(bufa, bufb, e_, 0); s_h0 = h0_; s_cfix = cfix_; s_sb = sb_; } while (0)
#define GV_TOUCH(ba, bb) asm volatile("" :: "v"(ba[0]), "v"(ba[1]), "v"(ba[2]), "v"(ba[3]), "v"(ba[4]), "v"(ba[5]), "v"(bb[0]), "v"(bb[1]), "v"(bb[2]), "v"(bb[3]), "v"(bb[4]), "v"(bb[5]))
#define GV_FINISH(ts_, A_) do { const int t_ = t0 + (ts_); \
        const bf16* hp_ = H2b + (size_t)t_ * 1024; float* op_ = out + (size_t)t_ * 1024; asm volatile("" : "+s"(hp_), "+s"(op_)); \
        gh2 T_[8]; _Pragma("unroll") for (int k_ = 0; k_ < 8; ++k_) { \
            int a_ = __builtin_bit_cast(int, A_[k_]), b_ = a_; asm volatile("s_nop 1\n\tv_permlane32_swap_b32 %0, %1" : "+v"(a_), "+v"(b_)); const gh2 lo_ = __builtin_bit_cast(gh2, a_) + __builtin_bit_cast(gh2, b_); \
            int c_ = __builtin_bit_cast(int, A_[8 + k_]), d_ = c_; asm volatile("s_nop 1\n\tv_permlane32_swap_b32 %0, %1" : "+v"(c_), "+v"(d_)); const gh2 hi_ = __builtin_bit_cast(gh2, c_) + __builtin_bit_cast(gh2, d_); \
            T_[k_] = half ? hi_ : lo_; } \
        float h_[16]; _Pragma("unroll") for (int jr_ = 0; jr_ < 4; ++jr_) { const v2u w_ = *(const GAS v2u*)((const char*)hp_ + eb * 2u + 256 * jr_); \
            h_[4 * jr_] = bf_lo(w_.x) + (float)T_[2 * jr_][0] * (1.f / 256.f); h_[4 * jr_ + 1] = bf_hi(w_.x) + (float)T_[2 * jr_][1] * (1.f / 256.f); \
            h_[4 * jr_ + 2] = bf_lo(w_.y) + (float)T_[2 * jr_ + 1][0] * (1.f / 256.f); h_[4 * jr_ + 3] = bf_hi(w_.y) + (float)T_[2 * jr_ + 1][1] * (1.f / 256.f); } \
        float ss_ = 0.f; _Pragma("unroll") for (int j_ = 0; j_ < 16; ++j_) ss_ += h_[j_] * h_[j_]; \
        const float r2_ = rsqrtf(wave_sum(ss_) * (1.f / 1024.f) + EPS); \
        _Pragma("unroll") for (int jr_ = 0; jr_ < 4; ++jr_) { const f32x4 g_ = *(const GAS f32x4*)((const char*)fg + eb * 4u + 512 * jr_); \
            const f32x4 ov_ = (f32x4){h_[4 * jr_] * r2_ * g_.x, h_[4 * jr_ + 1] * r2_ * g_.y, h_[4 * jr_ + 2] * r2_ * g_.z, h_[4 * jr_ + 3] * r2_ * g_.w}; \
            if (PROBE == 0 || ov_.x == 12345.678f) __builtin_nontemporal_store(ov_, (GAS f32x4*)((char*)op_ + eb * 4u + 512 * jr_)); } } while (0)
template <int PROBE> __device__ __forceinline__ void p6_gather(Frame& F, const Args& A) {
    const bf16* H2b = WSB(WS_XB); const unsigned char *U = F.ws + WS_U, *V = F.ws + WS_V;
    const float *ssq2 = F.sm + SM_SSQ2, *SU = F.sm + SM_SU, *SV = F.sm + SM_SV, *fg = IN_final_g; const int* IDX = (const int*)(F.ws + WS_IDX); const float* GATE = (const float*)(F.ws + WS_GATE); float* out = A.out;
    const int lane = F.lane, l15 = lane & 15, half = lane >> 5, gw = F.vcu * NWAVES + F.wave, NGW = F.G * NWAVES; const unsigned voff = (unsigned)lane * 16u;
    const unsigned voff6a = (unsigned)(lane & 31) * 16u, voff6b = 512u + (unsigned)(lane & 31) * 8u, eb = 512u * (unsigned)half + 4u * (unsigned)(lane & 31);
    LAS int* wl = (LAS int*)(F.lds + F.wave * 12544);
    LAS int* wll = wl + lane; asm volatile("" : "+v"(wll));
    for (int tb = gw; tb < M / 8; tb += NGW) {
        const int t0 = tb * 8;
        int hq[8][4], offv[8];
#pragma unroll
        for (int ts = 0; ts < 8; ++ts) {
            const int t = t0 + ts;
            const int* ip_ = IDX + (size_t)t * 128; const float* gp_ = GATE + (size_t)t * 128; const bf16* hp_ = H2b + (size_t)t * 1024; const float* sp_ = ssq2 + (size_t)t * 16;
            asm volatile("" : "+s"(ip_), "+s"(gp_), "+s"(hp_), "+s"(sp_));
            const unsigned l4 = voff >> 2;
            const int i0 = __builtin_nontemporal_load((const GAS int*)((const char*)ip_ + l4)), i1 = __builtin_nontemporal_load((const GAS int*)((const char*)ip_ + l4 + 256));
            const float gt0 = __builtin_nontemporal_load((const GAS float*)((const char*)gp_ + l4)), gt1 = __builtin_nontemporal_load((const GAS float*)((const char*)gp_ + l4 + 256));
            const v4u ha = *(const GAS v4u*)((const char*)hp_ + voff * 2u), hb = *(const GAS v4u*)((const char*)hp_ + voff * 2u + 16);
            float rs = lane < 16 ? *(const GAS float*)((const char*)sp_ + l4) : 0.f;
            rs = wave_sum(rs);
            float h[16]; { float a8[8], b8[8]; unpack8(ha, a8); unpack8(hb, b8);
#pragma unroll
                for (int j = 0; j < 8; ++j) { h[j] = a8[j]; h[8 + j] = b8[j]; } }
            float am = 0.f;
#pragma unroll
            for (int j = 0; j < 16; ++j) am = fmaxf(am, fabsf(h[j]));
            am = wave_max(am); const float inv = am > 0.f ? 127.f / am : 0.f;
            if (lane == 0) GL_DSC[ts] = __builtin_bit_cast(int, am * (1.f / 127.f) * rsqrtf(rs * (1.f / 1024.f) + EPS));
#pragma unroll
for (int j = 0; j < 4; ++j) {
                const unsigned f0 = __builtin_bit_cast(unsigned, __builtin_fmaf(h[4 * j], inv, 12582912.f)), f1 = __builtin_bit_cast(unsigned, __builtin_fmaf(h[4 * j + 1], inv, 12582912.f));
                const unsigned f2 = __builtin_bit_cast(unsigned, __builtin_fmaf(h[4 * j + 2], inv, 12582912.f)), f3 = __builtin_bit_cast(unsigned, __builtin_fmaf(h[4 * j + 3], inv, 12582912.f));
                hq[ts][j] = (int)(__builtin_amdgcn_perm(f1, f0, 0x0c0c0400u) | __builtin_amdgcn_perm(f3, f2, 0x04000c0cu)); }
            const int k0 = i0 >> 10, k1 = i1 >> 10, d0 = k0 >> 2, d1 = k1 >> 2, sh0 = (k0 & 3) << 3, sh1 = (k1 & 3) << 3;
            const unsigned o0 = 1u << sh0, o1 = 1u << sh1;
            unsigned Wk[4]; unsigned absb[4]; unsigned car = 0u;
#pragma unroll
            for (int d = 0; d < 4; ++d) {
                const unsigned pk = (d0 == d ? o0 : 0u) + (d1 == d ? o1 : 0u);
                int v = (int)pk;
                v += __builtin_amdgcn_update_dpp(0, v, 0x111, 0xf, 0xf, false); v += __builtin_amdgcn_update_dpp(0, v, 0x112, 0xf, 0xf, false);
                v += __builtin_amdgcn_update_dpp(0, v, 0x114, 0xf, 0xf, false); v += __builtin_amdgcn_update_dpp(0, v, 0x118, 0xf, 0xf, false);
                v += __builtin_amdgcn_update_dpp(0, v, 0x142, 0xa, 0xf, false); v += __builtin_amdgcn_update_dpp(0, v, 0x143, 0xc, 0xf, false);
                const unsigned tot = (unsigned)__builtin_amdgcn_readlane(v, 63), incl = tot * 0x01010101u;
                absb[d] = (incl - tot) + car * 0x01010101u;
                car += incl >> 24;
                Wk[d] = ((unsigned)v - pk) + absb[d];
            }
            const unsigned w0s = d0 == 0 ? Wk[0] : d0 == 1 ? Wk[1] : d0 == 2 ? Wk[2] : Wk[3], w1s = d1 == 0 ? Wk[0] : d1 == 1 ? Wk[1] : d1 == 2 ? Wk[2] : Wk[3];
            const int p0 = (int)((w0s >> sh0) & 255u), p1 = (int)((w1s >> sh1) & 255u) + (k0 == k1 ? 1 : 0);
            const int cd = (lane >> 2) & 3; const unsigned abl = cd == 0 ? absb[0] : cd == 1 ? absb[1] : cd == 2 ? absb[2] : absb[3];
            const int ov = lane >= 16 ? 128 : (int)((abl >> ((lane & 3) << 3)) & 255u);
            offv[ts] = ov;
            { LAS int* w0 = wl + p0; LAS int* w1 = wl + p1; w0[ts * 128] = i0; w1[ts * 128] = i1; w0[1024 + ts * 128] = __builtin_bit_cast(int, gt0); w1[1024 + ts * 128] = __builtin_bit_cast(int, gt1); }
        }
        if constexpr (!(PROBE & 2)) {
            v4u bX[16], bY[16];
#pragma unroll
            for (int j = 0; j < 16; ++j) { bX[j] = (v4u){0u, 0u, 0u, 0u}; bY[j] = (v4u){0u, 0u, 0u, 0u}; }
            int su_off, su_n; { GU_EV(0, 0) GU_ISSUE2(bX); su_off = poff_; su_n = pn_; }
#pragma unroll 1
            for (int c = 0; c < 16; ++c) {
                const int cn = c < 15 ? c + 1 : c;
                GU_STEPM(bX, bY, c, 1, c, 0)
                GU_STEPM(bY, bX, c, 2, c, 1)
                GU_STEPM(bX, bY, c, 3, c, 2)
                GU_STEPM(bY, bX, c, 4, c, 3)
                GU_STEPM(bX, bY, c, 5, c, 4)
                GU_STEPM(bY, bX, c, 6, c, 5)
                GU_STEPM(bX, bY, c, 7, c, 6)
                GU_STEPM(bY, bX, cn, 0, c, 7)
            }
        }
#pragma unroll
        for (int ts = 0; ts < 8; ++ts) {
            const int e0 = wll[(ts) * 128], e1 = wll[(ts) * 128 + 64];
            const float gt0 = __builtin_bit_cast(float, wll[1024 + (ts) * 128]), gt1 = __builtin_bit_cast(float, wll[1024 + (ts) * 128 + 64]);
            const int d0 = wll[2048 + (ts) * 128], d1 = wll[2048 + (ts) * 128 + 64];
            const float su0 = SU[e0], su1 = SU[e1], sv0 = SV[e0], sv1 = SV[e1], dsc_ = __builtin_bit_cast(float, GL_DSC[ts]);
            const float coef0 = gt0 * gelu_fast((float)d0 * su0 * dsc_) * sv0, coef1 = gt1 * gelu_fast((float)d1 * su1 * dsc_) * sv1;
            { const _Float16 c0h = (_Float16)(coef0 * 256.f), c1h = (_Float16)(coef1 * 256.f);
              wll[1024 + (ts) * 128] = __builtin_bit_cast(int, (gh2){c0h, c0h}); wll[1024 + (ts) * 128 + 64] = __builtin_bit_cast(int, (gh2){c1h, c1h}); }
        }
#pragma unroll 1
        for (int sp = (PROBE & 1) ? 2 : 0; sp < 2; ++sp) {
            gh2 a0[16], a1[16], a2[16], a3[16];
#pragma unroll
            for (int j = 0; j < 16; ++j) { a0[j] = (gh2){0, 0}; a1[j] = (gh2){0, 0}; a2[j] = (gh2){0, 0}; a3[j] = (gh2){0, 0}; }
            v4u bX[GV_PAIRS], bY[GV_PAIRS]; v2u cX[GV_PAIRS], cY[GV_PAIRS];
#pragma unroll
            for (int j = 0; j < GV_PAIRS; ++j) { bX[j] = (v4u){0u, 0u, 0u, 0u}; bY[j] = (v4u){0u, 0u, 0u, 0u}; cX[j] = (v2u){0u, 0u}; cY[j] = (v2u){0u, 0u}; }
            if (sp == 0) {
                int s_h0, s_cfix; const LAS int* s_sb; GV_PREP0(bX, cX, 0, 0);
#pragma unroll 1
                for (int c = 0; c < 16; ++c) {
                    const int cn = c < 15 ? c + 1 : c;
                    GV_STEPM(bX, cX, bY, cY, c, 1, c, 0, a0)
                    GV_STEPM(bY, cY, bX, cX, c, 2, c, 1, a1)
                    GV_STEPM(bX, cX, bY, cY, c, 3, c, 2, a2)
                    GV_STEPM(bY, cY, bX, cX, cn, 0, c, 3, a3)
                }
                GV_FINISH(0, a0); GV_FINISH(1, a1); GV_FINISH(2, a2); GV_FINISH(3, a3);
            } else {
                int s_h0, s_cfix; const LAS int* s_sb; GV_PREP0(bX, cX, 0, 4);
#pragma unroll 1
                for (int c = 0; c < 16; ++c) {
                    const int cn = c < 15 ? c + 1 : c;
                    GV_STEPM(bX, cX, bY, cY, c, 5, c, 4, a0)
                    GV_STEPM(bY, cY, bX, cX, c, 6, c, 5, a1)
                    GV_STEPM(bX, cX, bY, cY, c, 7, c, 6, a2)
                    GV_STEPM(bY, cY, bX, cX, cn, 4, c, 7, a3)
                }
                GV_FINISH(4, a0); GV_FINISH(5, a1); GV_FINISH(6, a2); GV_FINISH(7, a3);
            }
        }
    }
}
typedef short tk_bf16x8 __attribute__((ext_vector_type(8)));
typedef float tk_f32x16 __attribute__((ext_vector_type(16)));
__device__ __forceinline__ void tk_ins16(float (&t)[16], float x) {
#pragma unroll
    for (int j = 15; j >= 1; --j) t[j] = __builtin_amdgcn_fmed3f(t[j - 1], t[j], x);
    t[0] = __builtin_fmaxf(t[0], x);
}
__device__ __forceinline__ void tk_sort_bitonic16(float (&c)[16]) {
#pragma unroll
    for (int st = 8; st >= 1; st >>= 1)
#pragma unroll
        for (int i = 0; i < 16; ++i) if ((i & st) == 0) { const float hi = __builtin_fmaxf(c[i], c[i + st]), lo = __builtin_fminf(c[i], c[i + st]); c[i] = hi; c[i + st] = lo; }
}
__device__ __forceinline__ void tk_merge_pair(float (&t)[16]) {
    float b[16];
#pragma unroll
    for (int i = 0; i < 16; ++i) b[i] = __shfl_xor(t[i], 32);
#pragma unroll
    for (int i = 0; i < 16; ++i) t[i] = __builtin_fmaxf(t[i], b[15 - i]);
    tk_sort_bitonic16(t);
}
template <int PROBE> __device__ __forceinline__ void tk_side(const LAS unsigned char* klds, const bf16* keys, const bf16* qrow, int lane, float (&t)[16]) {
    const int r32 = lane & 31, h = lane >> 5;
    tk_f32x16 acc[4];
#ifdef TK_EXPERIMENT_VALU
#pragma unroll
    for (int mt = 0; mt < 4; ++mt)
#pragma unroll
        for (int r = 0; r < 16; ++r) {
            const int key = 32 * mt + (r & 3) + 8 * (r >> 2) + 4 * h; float s = 0.f;
            for (int k = 0; k < 128; ++k) s += bf2f(qrow[k]) * bf2f(keys[key * 128 + k]);
            acc[mt][r] = s;
        }
#else
    tk_bf16x8 qf[8];
#pragma unroll
    for (int ks = 0; ks < 8; ++ks) qf[ks] = *(const GAS tk_bf16x8*)(qrow + 16 * ks + 8 * h);
    tk_bf16x8 kf[2][4];
#define TK_KLD(b_, ks_) do { _Pragma("unroll") for (int mt = 0; mt < 4; ++mt) { const int row = 32 * mt + r32;     \
        kf[b_][mt] = *(const LAS tk_bf16x8*)(klds + row * 256 + (((2 * (ks_) + h) ^ (row & 15)) << 4)); } } while (0)
#pragma unroll
    for (int mt = 0; mt < 4; ++mt) acc[mt] = (tk_f32x16){0.f, 0.f, 0.f, 0.f, 0.f, 0.f, 0.f, 0.f, 0.f, 0.f, 0.f, 0.f, 0.f, 0.f, 0.f, 0.f};
    TK_KLD(0, 0);
#pragma unroll
    for (int ks = 0; ks < 8; ++ks) {
        __builtin_amdgcn_sched_barrier(0);
        if (ks + 1 < 8) TK_KLD((ks + 1) & 1, ks + 1);
        __builtin_amdgcn_sched_barrier(0);
#pragma unroll
        for (int mt = 0; mt < 4; ++mt) acc[mt] = __builtin_amdgcn_mfma_f32_32x32x16_bf16(kf[ks & 1][mt], qf[ks], acc[mt], 0, 0, 0);
    }
#undef TK_KLD
#endif
#pragma unroll
    for (int j = 0; j < 16; ++j) t[j] = -3.0e38f;
    const unsigned h4 = (unsigned)h << 2;
#pragma unroll
    for (int mt = 0; mt < 4; ++mt)
#pragma unroll
        for (int r = 0; r < 16; ++r) {
            const unsigned key = (unsigned)(32 * mt + (r & 3) + 8 * (r >> 2)) | h4;
            const float av = acc[mt][r];
            const float x = __builtin_bit_cast(float, (__builtin_bit_cast(unsigned, av) & ~127u) | key);
            if constexpr (!(PROBE & 256)) tk_ins16(t, x); else t[r] = __builtin_fmaxf(t[r], x);
        }
    tk_merge_pair(t);
}
template <int PROBE> __device__ __forceinline__ void p5_topk(Frame& F, const Args& A, const pg8::StaticOrder& S) {
    const bf16 *Qp = WSB(WS_P), *Keys = WSB(WS_KEYS); const float* ssq2 = F.sm + SM_SSQ2; int* IDX = (int*)(F.ws + WS_IDX); float* GATE = (float*)(F.ws + WS_GATE);
    const int lane = lane_id64(), h = lane >> 5, tid_ = F.wave * 64 + lane;
    for (int c = tid_; c < 4096; c += NWAVES * 64) {
        const int row = (c >> 4) & 127, ch = c & 15;
        const v4u v = *(const GAS v4u*)(Keys + (size_t)c * 8);
        *(LAS v4u*)(F.lds + (c >> 11) * 32768 + row * 256 + ((ch ^ (row & 15)) << 4)) = v;
    }
    __syncthreads();
    pg8::Unit u;
    for (int i = 0; S.next(i, u); ++i) {
        const int row = u.pm * 256 + 32 * F.wave + (lane & 31), head = u.pn;
        const bf16* qrow = Qp + (size_t)row * 2048 + head * 256;
        float v1[16], v2[16];
        tk_side<PROBE>(F.lds, Keys, qrow, lane, v1);
        __builtin_amdgcn_sched_barrier(0);
        tk_side<PROBE>(F.lds + 32768, Keys + 16384, qrow + 128, lane, v2);
        __builtin_amdgcn_sched_barrier(0);
        if constexpr (PROBE & 128) { if (v1[0] + v2[0] == 12345.678f) IDX[row] = 1; continue; }
        float rs = 0.f;
        { const f32x4 a = *(const GAS f32x4*)(ssq2 + row * 16), b = *(const GAS f32x4*)(ssq2 + row * 16 + 4), c = *(const GAS f32x4*)(ssq2 + row * 16 + 8), d = *(const GAS f32x4*)(ssq2 + row * 16 + 12);
          rs = ((a.x + a.y) + (a.z + a.w)) + ((b.x + b.y) + (b.z + b.w)) + ((c.x + c.y) + (c.z + c.w)) + ((d.x + d.y) + (d.z + d.w)); }
        const float rs2l = rsqrtf(rs * (1.f / 1024.f) + EPS) * 1.4426950408889634f;
        unsigned k1m[16], k2m[16];
#pragma unroll
        for (int j = 0; j < 16; ++j) { k1m[j] = (__builtin_bit_cast(unsigned, v1[j]) & 127u) << 7; k2m[j] = __builtin_bit_cast(unsigned, v2[j]) & 127u; }
        float t[16];
#pragma unroll
        for (int j = 0; j < 16; ++j) t[j] = -3.0e38f;
#define TK_X(i, ae, be, ao, bo) const float s_ = (h ? v1[ao] : v1[ae]) + (h ? v2[bo] : v2[be]); \
            const float x_ = __builtin_bit_cast(float, (__builtin_bit_cast(unsigned, s_) & ~63u) | (unsigned)(2 * (i)) | (unsigned)h);
#define TK_CAND(i, ae, be, ao, bo) { TK_X(i, ae, be, ao, bo) tk_ins16(t, x_); }
    TK_CAND(0, 0, 0, 0, 1)
    TK_CAND(1, 0, 2, 0, 3)
    TK_CAND(2, 0, 4, 0, 5)
    TK_CAND(3, 0, 6, 0, 7)
    TK_CAND(4, 0, 8, 0, 9)
    TK_CAND(5, 0, 10, 0, 11)
    TK_CAND(6, 0, 12, 0, 13)
    TK_CAND(7, 0, 14, 0, 15)
    TK_CAND(8, 1, 0, 1, 1)
    TK_CAND(9, 1, 2, 1, 3)
    TK_CAND(10, 1, 4, 1, 5)
    TK_CAND(11, 1, 6, 1, 7)
    TK_CAND(12, 2, 0, 2, 1)
    TK_CAND(13, 2, 2, 2, 3)
    TK_CAND(14, 2, 4, 3, 0)
    TK_CAND(15, 3, 1, 3, 2)
    TK_CAND(16, 3, 3, 4, 0)
    TK_CAND(17, 4, 1, 4, 2)
    TK_CAND(18, 5, 0, 5, 1)
    TK_CAND(19, 6, 0, 6, 1)
    TK_CAND(20, 7, 0, 7, 1)
    TK_CAND(21, 8, 0, 9, 0)
    TK_CAND(22, 10, 0, 11, 0)
    TK_CAND(23, 12, 0, 13, 0)
    TK_CAND(24, 14, 0, 15, 0)
#undef TK_CAND
        tk_merge_pair(t);
        __builtin_amdgcn_sched_barrier(0);
        float den = 0.f;
#pragma unroll
        for (int j = 0; j < 16; ++j) den += __builtin_amdgcn_exp2f((t[j] - t[0]) * rs2l);
        const float inv = 1.f / den, thr = t[15], top = t[0];
        int pos = h ? 15 : 0; const int step = h ? -1 : 1;
        LAS int* sti = (LAS int*)(F.lds + 65536 + F.wave * 4352) + (lane & 31) * 17;
#define TK_CAND(i, ae, be, ao, bo) { TK_X(i, ae, be, ao, bo) const bool sel = x_ >= thr; \
            if (sel) { sti[pos] = (int)((h ? k1m[ao] : k1m[ae]) | (h ? k2m[bo] : k2m[be])); sti[544 + pos] = __builtin_bit_cast(int, __builtin_amdgcn_exp2f((x_ - top) * rs2l) * inv); } \
            pos += sel ? step : 0; }
    TK_CAND(0, 0, 0, 0, 1)
    TK_CAND(1, 0, 2, 0, 3)
    TK_CAND(2, 0, 4, 0, 5)
    TK_CAND(3, 0, 6, 0, 7)
    TK_CAND(4, 0, 8, 0, 9)
    TK_CAND(5, 0, 10, 0, 11)
    TK_CAND(6, 0, 12, 0, 13)
    TK_CAND(7, 0, 14, 0, 15)
    TK_CAND(8, 1, 0, 1, 1)
    TK_CAND(9, 1, 2, 1, 3)
    TK_CAND(10, 1, 4, 1, 5)
    TK_CAND(11, 1, 6, 1, 7)
    TK_CAND(12, 2, 0, 2, 1)
    TK_CAND(13, 2, 2, 2, 3)
    TK_CAND(14, 2, 4, 3, 0)
    TK_CAND(15, 3, 1, 3, 2)
    TK_CAND(16, 3, 3, 4, 0)
    TK_CAND(17, 4, 1, 4, 2)
    TK_CAND(18, 5, 0, 5, 1)
    TK_CAND(19, 6, 0, 6, 1)
    TK_CAND(20, 7, 0, 7, 1)
    TK_CAND(21, 8, 0, 9, 0)
    TK_CAND(22, 10, 0, 11, 0)
    TK_CAND(23, 12, 0, 13, 0)
    TK_CAND(24, 14, 0, 15, 0)
#undef TK_CAND
#undef TK_X
        {   const LAS int* stw = (const LAS int*)(F.lds + 65536 + F.wave * 4352); const int part = lane & 3;
#pragma unroll
            for (int i = 0; i < 2; ++i) {
                const int tok = (lane >> 2) + 16 * i; const LAS int* sp = stw + tok * 17 + 4 * part;
                const v4u iv = {(unsigned)sp[0], (unsigned)sp[1], (unsigned)sp[2], (unsigned)sp[3]}, gv = {(unsigned)sp[544], (unsigned)sp[545], (unsigned)sp[546], (unsigned)sp[547]};
                const size_t o = (size_t)(u.pm * 256 + 32 * F.wave + tok) * 128 + head * 16 + 4 * part;
                *(GAS v4u*)(IDX + o) = iv; *(GAS v4u*)(GATE + o) = gv;
            }
        }
    }
}
namespace att {
typedef short bf16x8 __attribute__((ext_vector_type(8)));
typedef short s16x4 __attribute__((ext_vector_type(4)));
typedef float f32x16 __attribute__((ext_vector_type(16)));
constexpr int KT = 12288, VT = 8192, SLOT = KT + VT;
constexpr int WSF_OFF = 2 * SLOT, OST_OFF = WSF_OFF + NWAVES * 256, LDS_NEED = OST_OFF + NWAVES * 4096;
static_assert(LDS_NEED <= RING_BYTES, "attention LDS");
constexpr float NEG = -1.0e30f;
__device__ __forceinline__ int crow(int r, int hi) { return (r & 3) + 8 * (r >> 2) + 4 * hi; }
__device__ __forceinline__ unsigned cvtpk(float lo, float hi) { typedef float f2 __attribute__((ext_vector_type(2))); typedef __bf16 b2 __attribute__((ext_vector_type(2))); f2 v = {lo, hi}; b2 b = __builtin_convertvector(v, b2); return __builtin_bit_cast(unsigned, b); }
__device__ __forceinline__ s16x4 vtr(const LAS unsigned char* p) { typedef short v4i16_t __attribute__((ext_vector_type(4))); return __builtin_bit_cast(s16x4, __builtin_amdgcn_ds_read_tr16_b64_v4i16((LAS v4i16_t*)p)); }
__device__ __forceinline__ float max3f(float a, float b, float c) { float r; asm("v_max3_f32 %0, %1, %2, %3" : "=v"(r) : "v"(a), "v"(b), "v"(c)); return r; }
__device__ __forceinline__ float max2f(float a, float b) { float r; asm("v_max_f32_e32 %0, %1, %2" : "=v"(r) : "v"(a), "v"(b)); return r; }
__device__ __forceinline__ void glds16(const void* g, LAS unsigned char* l) { __builtin_amdgcn_global_load_lds((const unsigned*)g, (LAS unsigned*)l, 16, 0, 0); }

template <int PROBE> __device__ __forceinline__ void attn_unit(LAS unsigned char* lds, int b, int h, int qb, const bf16* Q, const bf16* KN, const bf16* VV, const bf16* KR, bf16* MIX, float* ssqatt, int wave, int lane) {
    lane = lane_id64();
    const int r32 = lane & 31, hi = lane >> 5;
    const size_t kb = (size_t)b * KVROWS;
    const int NT = 4 * qb + 5;
    const int row0 = b * SEQ + qb * 256 + wave * 32;
    const int qrel = wave * 32 + r32;
    bf16x8 qf[6];
    { const bf16* qp = Q + (size_t)(row0 + r32) * 768 + h * 96 + 8 * hi;
#pragma unroll
      for (int ks = 0; ks < 6; ++ks) qf[ks] = *(const GAS bf16x8*)(qp + 16 * ks); }
    const bf16* ksrc0 = KN + (kb + 8 * wave + (lane >> 3)) * 512 + h * 64 + ((lane & 7) ^ ((4 * wave + (lane >> 4)) & 7)) * 8;
    const bf16* ksrc1 = KR + (kb + 16 * (wave & 3) + (lane >> 2)) * 32 + ((lane & 3) ^ ((lane >> 4) & 3)) * 8;
    const bf16* vsrc = VV + (kb + 16 * (wave & 3) + (lane >> 2)) * 512 + h * 64 + (wave >> 2) * 32 + (lane & 3) * 8;
#define ATT_DMA(t, slot) do { LAS unsigned char* s_ = lds + (slot) * SLOT; glds16(ksrc0 + (size_t)(t) * (64 * 512), s_ + wave * 1024); \
        if (wave < 4) glds16(ksrc1 + (size_t)(t) * (64 * 32), s_ + (8 + wave) * 1024); glds16(vsrc + (size_t)(t) * (64 * 512), s_ + KT + wave * 1024); } while (0)
    LAS float* wsf = (LAS float*)(lds + WSF_OFF + wave * 256);
    const int kfn = r32 * 128, kfr = 8192 + r32 * 64, ksw = (r32 >> 1) & 7, ksr = (r32 >> 2) & 3;
    const int vfo = ((lane >> 4) & 1) * 32 + (lane & 3) * 8 + (4 * hi + ((lane & 15) >> 2)) * 64;
    constexpr float THR = 8.0f;
    float m = 0.f;
    f32x16 o0, o1, o2, negm;
#pragma unroll
    for (int r = 0; r < 16; ++r) { o0[r] = 0.f; o1[r] = 0.f; o2[r] = 0.f; negm[r] = 0.f; }
    const bf16x8 ones = {0x3F80, 0x3F80, 0x3F80, 0x3F80, 0x3F80, 0x3F80, 0x3F80, 0x3F80};
    ATT_DMA(0, 0);
    for (int t = 0; t < NT; ++t) {
        asm volatile("s_waitcnt vmcnt(0)" ::: "memory"); __builtin_amdgcn_s_barrier(); asm volatile("" ::: "memory");
        if (t + 1 < NT) { if constexpr (!(PROBE & 32)) ATT_DMA(t + 1, (t + 1) & 1); }
        const int jb = t - (NT - 4);
        if constexpr (PROBE & 512) { if (wave >= 4) continue; }
        if (jb >= 1 && 64 * jb > wave * 32 + 31) continue;
        const LAS unsigned char* kbuf = lds + (t & 1) * SLOT; const LAS unsigned char* vbuf = kbuf + KT;
        f32x16 p0, p1;
        p0 = negm; p1 = negm;
        if constexpr (!(PROBE & 16)) {
#define ATT_KO(ks) ((ks) < 4 ? kfn + (((2 * (ks) + hi) ^ ksw) << 4) : kfr + (((2 * ((ks) - 4) + hi) ^ ksr) << 4))
#define ATT_KLD(i, ks) do { const unsigned ad_ = (unsigned)(unsigned long long)(kbuf + ATT_KO(ks)); asm volatile("ds_read_b128 %0, %1" : "=v"(ka[i]) : "v"(ad_)); \
            asm volatile("ds_read_b128 %0, %1 offset:%2" : "=v"(kc[i]) : "v"(ad_), "n"((ks) < 4 ? 4096 : 2048)); } while (0)
#define ATT_KW(n, i) do { __builtin_amdgcn_sched_barrier(0); asm volatile("s_waitcnt lgkmcnt(" #n ")" : "+v"(ka[i]), "+v"(kc[i])); } while (0)
#define ATT_KMM(i, ks, c0, c1) do { p0 = __builtin_amdgcn_mfma_f32_32x32x16_bf16(ka[i], qf[ks], c0, 0, 0, 0); p1 = __builtin_amdgcn_mfma_f32_32x32x16_bf16(kc[i], qf[ks], c1, 0, 0, 0); } while (0)
        bf16x8 ka[6], kc[6];
        ATT_KLD(0, 0); ATT_KLD(1, 1); ATT_KLD(2, 2); ATT_KLD(3, 3); ATT_KLD(4, 4); ATT_KLD(5, 5);
        __builtin_amdgcn_sched_barrier(0);
        ATT_KW(10, 0); ATT_KMM(0, 0, negm, negm); ATT_KW(8, 1); ATT_KMM(1, 1, p0, p1); ATT_KW(6, 2); ATT_KMM(2, 2, p0, p1); ATT_KW(4, 3); ATT_KMM(3, 3, p0, p1); ATT_KW(2, 4); ATT_KMM(4, 4, p0, p1); ATT_KW(0, 5); ATT_KMM(5, 5, p0, p1);
#undef ATT_KO
#undef ATT_KLD
#undef ATT_KW
#undef ATT_KMM
        }
        if (t == 0) {
            asm volatile("" ::: "memory");
#pragma unroll
            for (int r = 0; r < 16; ++r) p0[r] = NEG;
#pragma unroll
            for (int r = 0; r < 8; ++r) p1[r] = NEG;
        }
        if (jb >= 0) {
#pragma unroll
            for (int r = 0; r < 16; ++r) { const int kv = 64 * jb + crow(r, hi); if (kv > qrel) p0[r] = NEG; if (kv + 32 > qrel) p1[r] = NEG; }
        }
        float mx;
        { float a = max3f(p0[0], p0[1], p1[0]), b = max3f(p0[2], p0[3], p1[1]); a = max3f(a, p1[2], p1[3]);
#pragma unroll
          for (int r = 4; r < 16; r += 4) { a = max3f(a, p0[r], p0[r + 1]); b = max3f(b, p0[r + 2], p0[r + 3]); a = max3f(a, p1[r], p1[r + 1]); b = max3f(b, p1[r + 2], p1[r + 3]); }
          float ma = max2f(a, b), mb = ma;
          asm volatile("s_nop 1\n\tv_permlane32_swap_b32 %0, %1" : "+v"(ma), "+v"(mb)); mx = max2f(ma, mb); }
        if (__builtin_expect(__any(mx > THR), 0)) {
            const float dl = __builtin_fmaxf(mx, 0.f), f = __builtin_amdgcn_exp2f(-dl);
            m += dl;
#pragma unroll
            for (int r = 0; r < 16; ++r) { p0[r] -= dl; p1[r] -= dl; negm[r] = -m; }
            if (hi == 0) wsf[r32] = f;
            asm volatile("s_waitcnt lgkmcnt(0)" ::: "memory");
#pragma unroll
            for (int g = 0; g < 4; ++g) { const f32x4 a4 = *(const LAS f32x4*)(wsf + 8 * g + 4 * hi);
#pragma unroll
                for (int j = 0; j < 4; ++j) { o0[4 * g + j] *= a4[j]; o1[4 * g + j] *= a4[j]; o2[4 * g + j] *= a4[j]; } }
        }
#pragma unroll
        for (int r = 0; r < 16; ++r) { if constexpr (!(PROBE & 4)) { p0[r] = __builtin_amdgcn_exp2f(p0[r]); p1[r] = __builtin_amdgcn_exp2f(p1[r]); } }
        bf16x8 pa[4];
#pragma unroll
        for (int s = 0; s < 2; ++s) {
            const v4u w0 = {cvtpk(p0[8 * s], p0[8 * s + 1]), cvtpk(p0[8 * s + 2], p0[8 * s + 3]), cvtpk(p0[8 * s + 4], p0[8 * s + 5]), cvtpk(p0[8 * s + 6], p0[8 * s + 7])};
            const v4u w1 = {cvtpk(p1[8 * s], p1[8 * s + 1]), cvtpk(p1[8 * s + 2], p1[8 * s + 3]), cvtpk(p1[8 * s + 4], p1[8 * s + 5]), cvtpk(p1[8 * s + 6], p1[8 * s + 7])};
            pa[s] = __builtin_bit_cast(bf16x8, w0); pa[2 + s] = __builtin_bit_cast(bf16x8, w1);
        }
        if constexpr (!(PROBE & 8))
#pragma unroll
        for (int s = 0; s < 4; ++s) {
            const s16x4 l0 = vtr(vbuf + s * 1024 + vfo), h0 = vtr(vbuf + s * 1024 + vfo + 512);
            const s16x4 l1 = vtr(vbuf + 4096 + s * 1024 + vfo), h1 = vtr(vbuf + 4096 + s * 1024 + vfo + 512);
            const bf16x8 b0 = {l0[0], l0[1], l0[2], l0[3], h0[0], h0[1], h0[2], h0[3]}, b1 = {l1[0], l1[1], l1[2], l1[3], h1[0], h1[1], h1[2], h1[3]};
            o0 = __builtin_amdgcn_mfma_f32_32x32x16_bf16(pa[s], b0, o0, 0, 0, 0);
            o1 = __builtin_amdgcn_mfma_f32_32x32x16_bf16(pa[s], b1, o1, 0, 0, 0);
            o2 = __builtin_amdgcn_mfma_f32_32x32x16_bf16(pa[s], ones, o2, 0, 0, 0);
        }
    }
#undef ATT_DMA
    LAS bf16* stg = (LAS bf16*)(lds + OST_OFF + wave * 4096);
#pragma unroll
    for (int r = 0; r < 16; ++r) { const int orow = crow(r, hi); const float rl = __builtin_amdgcn_rcpf(o2[r]);
        stg[orow * 64 + r32] = (bf16)f2bf(o0[r] * rl); stg[orow * 64 + 32 + r32] = (bf16)f2bf(o1[r] * rl); }
    asm volatile("s_waitcnt lgkmcnt(0)" ::: "memory");
#pragma unroll
    for (int i = 0; i < 4; ++i) {
        const int row = i * 8 + (lane >> 3), ch = lane & 7;
        const v4u v = *(const LAS v4u*)(stg + row * 64 + ch * 8);
        *(GAS v4u*)(MIX + (size_t)(row0 + row) * 1024 + h * 64 + ch * 8) = v;
        float f[8]; unpack8(v, f);
        float ss = (f[0] * f[0] + f[1] * f[1]) + (f[2] * f[2] + f[3] * f[3]) + (f[4] * f[4] + f[5] * f[5]) + (f[6] * f[6] + f[7] * f[7]);
        ss += __shfl_xor(ss, 1); ss += __shfl_xor(ss, 2); ss += __shfl_xor(ss, 4);
        if (ch == 0) ssqatt[(size_t)(row0 + row) * 8 + h] = ss;
    }
    asm volatile("s_waitcnt lgkmcnt(0)" ::: "memory"); __builtin_amdgcn_s_barrier(); asm volatile("" ::: "memory");
}
}
template <int PROBE> __device__ __forceinline__ void p3_attn(Frame& F, const Args& A) {
    const bf16 *Q = WSB(WS_Q), *KN = WSB(WS_KN), *VV = WSB(WS_VV), *KR = WSB(WS_KR); bf16* MIX = WSB(WS_MIX); float* ssqatt = F.sm + SM_SSQATT;
    const int slot = F.vcu % 3; bool tables_done = false;
    for (int item = F.vcu; item < 256; item += F.G) {
        const int bh = item >> 3, s = item & 7;
        if (slot == 0 && !tables_done) { p0_tables(F, A, 5); tables_done = true; __syncthreads(); }
        att::attn_unit<PROBE>(F.lds, bh >> 3, bh & 7, 15 - s, Q, KN, VV, KR, MIX, ssqatt, F.wave, F.lane);
        if (slot == 1 && !tables_done) { p0_tables(F, A, 5); tables_done = true; __syncthreads(); }
        att::attn_unit<PROBE>(F.lds, bh >> 3, bh & 7, s, Q, KN, VV, KR, MIX, ssqatt, F.wave, F.lane);
        if (slot == 2 && !tables_done) { p0_tables(F, A, 5); tables_done = true; __syncthreads(); }
    }
    if (!tables_done) p0_tables(F, A, 5);
}
template <int PROBE> __global__ void __launch_bounds__(NWAVES * 64, 2) mega(Args A) {
    extern __shared__ __attribute__((aligned(16))) unsigned char lds[];
    Frame F;
    F.lds = (LAS unsigned char*)lds;
    F.MISC = (volatile LAS unsigned*)(F.lds + MISC_OFF);
    F.tid = threadIdx.x; F.lane = F.tid & 63; F.wave = __builtin_amdgcn_readfirstlane(F.tid >> 6);
    F.G = gridDim.x; { const int bx = blockIdx.x; F.vcu = (F.G % 8 == 0) ? (bx % 8) * (F.G / 8) + bx / 8 : bx; }
    F.ws = A.ws; F.sm = (float*)(A.ws + WS_SMALL);
    for (int u = F.tid; u < (LDS_BYTES - LDSCTL_OFF) / 4; u += NWAVES * 64) ((LAS unsigned*)(F.lds + LDSCTL_OFF))[u] = 0u;
    __syncthreads();
    XcdBarrier bar = xcd_barrier_post((unsigned*)(A.ws + WS_CTL) + CW_BAR, F.MISC + 8, F.wave);
    const int lo = A.ph_lo, hi = A.ph_hi;
#define IN(k) (lo <= (k) && (k) < hi)
#ifndef PROBE_REPEAT_PHASE
#define PROBE_REPEAT_PHASE (-1)
#endif
#define REP(k) for (int rep_ = 0; rep_ < ((k) == PROBE_REPEAT_PHASE ? 2 : 1); ++rep_)
#define REP_BAR(k) do { if ((k) == PROBE_REPEAT_PHASE && rep_ == 0) GRID_BAR(); } while (0)
#define BOTH(k) (IN(k) && IN((k) + 1))
#define GRID_BAR() xcd_barrier(bar)
#define GRID_BAR_FILL(piece_) xcd_barrier_fill(bar, [&]() { p0_tables(F, A, (piece_)); })
#define SMP(off) ((float*)(A.ws + WS_SMALL) + (off))
#define FRESH_IDS() do { const int l_ = lane_id64(); F.lane = l_; F.tid = F.wave * 64 + l_; } while (0)
    if (IN(0)) { FRESH_IDS(); REP(0) { p0_prologue(F, A); REP_BAR(0); } if (BOTH(0)) GRID_BAR_FILL(0); }
    if (IN(1)) { FRESH_IDS(); REP(1) {
        p1_meta(F, A);
        pg8::Gemm g{WSB(WS_XB), WSB(WS_WIN), M, PN, 1024, 1024, 1024}; pg8::StaticOrder S; S.init(M, PN, F.G, (int)blockIdx.x);
        EpiInProj E{0, WSB(WS_P), SMP(SM_RSTD1), SMP(SM_SSQQ), SMP(SM_SSQKV), WSB(WS_KR), SMP(SM_ROPE)};
        pg8::gemm_phase<EpiInProj, pg8::StaticOrder, true, true>(F.lds + RING_OFF, g, S, E, F.wave);
        REP_BAR(1); }
        if (BOTH(1)) GRID_BAR_FILL(1);
    }
    if (IN(2)) { FRESH_IDS(); REP(2) {
        { pg8::Gemm g{WSB(WS_P) + O1, WSB(WS_WUKV), M, 1024, 128, PN, 128}; pg8::StaticOrder S; S.init(M, 1024, F.G, (int)blockIdx.x);
          EpiKV E{0, WSB(WS_KN), WSB(WS_VV), SMP(SM_SSQKV)};
          pg8::gemm_phase<EpiKV, pg8::StaticOrder, true, true>(F.lds + RING_OFF, g, S, E, F.wave); }
        { pg8::Gemm g{WSB(WS_P), WSB(WS_WUQ), M, 768, 256, PN, 256}; pg8::StaticOrder S; S.init(M, 768, F.G, (int)blockIdx.x);
          EpiQ E{0, WSB(WS_Q), SMP(SM_SSQQ), SMP(SM_ROPE)};
          pg8::gemm_phase<EpiQ, pg8::StaticOrder, true, true>(F.lds + RING_OFF, g, S, E, F.wave); }
        if (blockIdx.x >= 192 && F.G == 256) { FRESH_IDS(); p2_meta_kv(F, A, (int)blockIdx.x - 192); }
        else if (F.G != 256 && blockIdx.x < 64) { FRESH_IDS(); p2_meta_kv(F, A, (int)blockIdx.x); }
        FRESH_IDS();
        p2_conv(F, A);
        REP_BAR(2); }
        if (BOTH(2)) GRID_BAR_FILL(2);
    }
    if (IN(3)) { FRESH_IDS(); REP(3) { p3_attn<PROBE>(F, A); REP_BAR(3); } if (BOTH(3)) GRID_BAR_FILL(3); }
    if (IN(4)) { FRESH_IDS(); REP(4) {
        pg8::StaticOrder S; S.init(M, 1024, F.G, (int)blockIdx.x); pg8::Unit u0;
        LAS float* tab = (LAS float*)(F.lds + TAB_OFF);
        if (S.next(0, u0) && F.tid < 256) {
            const int row = u0.pm * 256 + F.tid; const float* q = SMP(SM_SSQATT) + row * 8; float s = 0.f;
#pragma unroll
            for (int j = 0; j < 8; ++j) s += q[j];
            tab[F.tid] = rsqrtf(s * (1.f / 512.f) + EPS);
        }
        __syncthreads();
        pg8::Gemm g{WSB(WS_MIX), WSB(WS_WOUT), M, 1024, 1024, 1024, 1024};
        EpiOut E{8, WSB(WS_XB)  , SMP(SM_SSQ2), tab};
        pg8::gemm_phase<EpiOut, pg8::StaticOrder, true, true>(F.lds + RING_OFF, g, S, E, F.wave);
        REP_BAR(4); }
        if (BOTH(4)) GRID_BAR_FILL(4);
    }
    if (IN(5)) { FRESH_IDS(); REP(5) {
        pg8::Gemm g{WSB(WS_XB), WSB(WS_WQ), M, 2048, 1024, 1024, 1024}; pg8::StaticOrder S; S.init(M, 2048, F.G, (int)blockIdx.x);
        EpiQp E{0, WSB(WS_P)};
        pg8::gemm_phase<EpiQp, pg8::StaticOrder, true, true>(F.lds + RING_OFF, g, S, E, F.wave);
        VM_WAIT(); __syncthreads();
        if (F.tid == 0) { __builtin_amdgcn_fence(__ATOMIC_ACQUIRE, "agent"); VM_WAIT(); }
        __syncthreads();
        if constexpr (!(PROBE & 64)) p5_topk<PROBE>(F, A, S);
        REP_BAR(5); }
        if (BOTH(5)) GRID_BAR();
    }
    if (IN(6)) { FRESH_IDS(); REP(6) {
        p6_gather<PROBE>(F, A); REP_BAR(6); }
    }
#undef IN
#undef BOTH
}
}
extern "C" void kernel_launch(void* const* d_in, const int* in_sizes, int n_in, void* d_out, int out_size, void* d_ws, size_t ws_size, hipStream_t stream) {
    static int grid = 0;
    if (grid == 0) {
        if (n_in != 20 || in_sizes[0] != M * D_MODEL || out_size != M * D_MODEL || ws_size < WS_END) { fprintf(stderr, "kernel_launch: unexpected shapes / workspace (%d, %d, %d, %zu)\n", n_in, n_in > 0 ? in_sizes[0] : -1, out_size, ws_size); grid = -1; return; }
        int dev = 0, cus = 0, per_cu = 0;
        if (hipGetDevice(&dev) != hipSuccess || hipDeviceGetAttribute(&cus, hipDeviceAttributeMultiprocessorCount, dev) != hipSuccess) { grid = -1; return; }
        if (hipFuncSetAttribute((const void*)mega<0>, hipFuncAttributeMaxDynamicSharedMemorySize, LDS_BYTES) != hipSuccess) { fprintf(stderr, "kernel_launch: hipFuncSetAttribute failed\n"); grid = -1; return; }
        if (hipOccupancyMaxActiveBlocksPerMultiprocessor(&per_cu, (const void*)mega<0>, NWAVES * 64, LDS_BYTES) != hipSuccess || per_cu < 1) fprintf(stderr, "kernel_launch: occupancy query says %d\n", per_cu);
        (void)hipGetLastError();
        grid = cus;
        if (grid != 256) fprintf(stderr, "kernel_launch: %d CUs (expected 256)\n", grid);
    }
    if (grid < 0) return;
    (void)hipMemsetAsync((char*)d_ws + WS_CTL, 0, CTL_ZERO_BYTES, stream);
    Args a{};
    for (int i = 0; i < 20; ++i) a.in[i] = (const float*)d_in[i];
    a.out = (float*)d_out; a.ws = (unsigned char*)d_ws;
    auto launch = [&](int lo, int hi) { a.ph_lo = lo; a.ph_hi = hi; hipLaunchKernelGGL(mega<0>, dim3(grid), dim3(NWAVES * 64), LDS_BYTES, stream, a); };
    launch(0, 7);
#ifdef PROBE_EXTRA_PHASE
#ifdef PROBE_MODE
    (void)hipFuncSetAttribute((const void*)mega<PROBE_MODE>, hipFuncAttributeMaxDynamicSharedMemorySize, LDS_BYTES);
    a.ph_lo = PROBE_EXTRA_PHASE; a.ph_hi = PROBE_EXTRA_PHASE + 1; hipLaunchKernelGGL(mega<PROBE_MODE>, dim3(grid), dim3(NWAVES * 64), LDS_BYTES, stream, a);
#else
    launch(PROBE_EXTRA_PHASE, PROBE_EXTRA_PHASE + 1);
#endif
#endif
}
```
